# Optimizing an MI355X kernel written in HIP

```python
import math
import jax, jax.numpy as jnp
from jax import lax
import numpy as np

D_MODEL = 1024
BATCH = 1
SEQ = 16384
DEPTH = 1
DEC_BATCH = 32
DEC_SEQ = 2048
PAST_LEN = 128

ATT_H = 8
ATT_KV = 2
ATT_G = ATT_H // ATT_KV
ATT_HD = 64
ATT_W = ATT_H * ATT_HD
ATT_KV_W = ATT_KV * ATT_HD
WINDOW = 128
BLK = 128
ATT_SCALE = 1.0 / math.sqrt(ATT_HD)
RW_H = 8
RW_N = 64
RW_W = RW_H * RW_N
DECAY_LORA = 64
AAA_LORA = 64
GATE_LORA = 160
RW_MIX_W = 3 * RW_W + 2 * DECAY_LORA + 2 * AAA_LORA + GATE_LORA
GATE_W = 2 * D_MODEL
IN_W = ATT_W + 2 * ATT_KV_W + RW_MIX_W + GATE_W
D_FF = 2816
NORM_EPS = 1e-6
GN_EPS = 64e-5

kernel_name = "hybrid_bidir_window_gqa_rwkv7_convglu"


def rms_norm(x, g):
    xf = x.astype(jnp.float32)
    y = xf * lax.rsqrt(jnp.mean(xf * xf, axis=-1, keepdims=True) + NORM_EPS)
    return (y * g.astype(jnp.float32)).astype(x.dtype)


def banded_gqa_alibi_sink(q, k, v, sink):
    B, T = q.shape[0], q.shape[1]
    nb = T // BLK
    kp = jnp.pad(k, ((0, 0), (BLK, BLK), (0, 0), (0, 0)))
    vp = jnp.pad(v, ((0, 0), (BLK, BLK), (0, 0), (0, 0)))
    slopes = jnp.exp2(-8.0 / ATT_H * jnp.arange(1, ATT_H + 1, dtype=jnp.float32)).reshape(ATT_KV, ATT_G)
    offs_q = jnp.arange(BLK)
    offs_k = jnp.arange(3 * BLK) - BLK
    dist = jnp.abs(offs_q[:, None] - offs_k[None, :])
    penalty = slopes[:, :, None, None] * dist.astype(jnp.float32)
    sink_b = sink.astype(jnp.float32).reshape(ATT_KV, ATT_G)[None, :, :, None, None]

    def block(i):
        start = i * BLK
        qb = lax.dynamic_slice_in_dim(q, start, BLK, axis=1)
        kb = lax.dynamic_slice_in_dim(kp, start, 3 * BLK, axis=1)
        vb = lax.dynamic_slice_in_dim(vp, start, 3 * BLK, axis=1)
        kpos = start - BLK + offs_k
        valid = (dist <= WINDOW) & ((kpos >= 0) & (kpos < T))[None, :]
        s = jnp.einsum('bqkgd,bskd->bkgqs', qb, kb).astype(jnp.float32) * ATT_SCALE - penalty
        s = jnp.where(valid, s, -jnp.inf)
        mx = jnp.maximum(jnp.max(s, axis=-1, keepdims=True), sink_b)
        p = jnp.exp(s - mx)
        den = jnp.sum(p, axis=-1, keepdims=True) + jnp.exp(sink_b - mx)
        return jnp.einsum('bkgqs,bskd->bqkgd', (p / den).astype(vb.dtype), vb)

    o = lax.map(block, jnp.arange(nb))
    return jnp.moveaxis(o, 0, 1).reshape(B, T, ATT_W)


def _heads(t):
    return t.reshape(t.shape[:-1] + (RW_H, RW_N))


def _scan_shared(t):
    tt = jnp.moveaxis(t, 1, 0)
    return jnp.stack([tt, tt[::-1]], axis=1)


def _scan_dir(t):
    tt = jnp.transpose(t, (1, 2, 0, 3, 4))
    return jnp.stack([tt[:, 0], tt[::-1, 1]], axis=1)


def _rwkv_step(S, inp):
    r, w, k, v, aa, bb = inp
    sa = jnp.einsum('dbhij,dbhj->dbhi', S, aa)
    S = S * w[..., None, :] + sa[..., :, None] * bb[..., None, :] + v[..., :, None] * k[..., None, :]
    y = jnp.einsum('dbhij,dbhj->dbhi', S, r)
    return S, y


def rwkv7_bidir(z, mu_prev, mu_next, w0, w2, a0, a2, g2, k_k, k_a, r_k, ln_w, ln_b):
    B, T, _ = z.shape
    z = z.astype(jnp.float32)
    zp = jnp.pad(z, ((0, 0), (1, 1), (0, 0)))
    z = z + mu_prev * (zp[:, :-2] - z) + mu_next * (zp[:, 2:] - z)
    o1 = RW_W; o2 = 2 * RW_W; o3 = 3 * RW_W
    o4 = o3 + 2 * DECAY_LORA; o5 = o4 + 2 * AAA_LORA
    r, k, v, wd, ad, gd = jnp.split(z, [o1, o2, o3, o4, o5], axis=-1)
    wd = wd.reshape(B, T, 2, DECAY_LORA)
    ad = ad.reshape(B, T, 2, AAA_LORA)
    w_log = -jax.nn.softplus(-(w0 + jnp.einsum('btdl,dlc->btdc', jnp.tanh(wd), w2))) - 0.5
    decay = jnp.exp(-jnp.exp(w_log))
    a = jax.nn.sigmoid(a0 + jnp.einsum('btdl,dlc->btdc', ad, a2))
    g = jnp.matmul(jax.nn.sigmoid(gd), g2)
    kk = _heads(k * k_k)
    kk = kk / jnp.maximum(jnp.sqrt(jnp.sum(kk * kk, axis=-1, keepdims=True)), 1e-12)
    k_dir = k[:, :, None, :] * (1.0 + (a - 1.0) * k_a)
    r_h, v_h = _heads(r), _heads(v)
    k_dir_h, decay_h, a_h = _heads(k_dir), _heads(decay), _heads(a)
    xs = (_scan_shared(r_h), _scan_dir(decay_h), _scan_dir(k_dir_h), _scan_shared(v_h),
          _scan_shared(-kk), _scan_dir(kk[:, :, None] * a_h))
    S0 = jnp.zeros((2, B, RW_H, RW_N, RW_N), jnp.float32)
    _, ys = lax.scan(_rwkv_step, S0, xs)
    y = jnp.moveaxis(ys[:, 0] + ys[::-1, 1], 0, 1)
    mu = jnp.mean(y, axis=-1, keepdims=True)
    var = jnp.mean(jnp.square(y - mu), axis=-1, keepdims=True)
    y = (y - mu) * lax.rsqrt(var + GN_EPS) * _heads(ln_w) + _heads(ln_b)
    bonus = jnp.sum(jnp.sum(r_h[:, :, None] * k_dir_h * r_k, axis=-1, keepdims=True), axis=2) * v_h
    return (y + bonus).reshape(B, T, RW_W) * g


def conv_glu_ffn(u, w_up, conv_w, conv_b, w_down):
    h = u @ w_up
    hp = jnp.pad(h, ((0, 0), (1, 1), (0, 0)))
    h = hp[:, :-2] * conv_w[0] + hp[:, 1:-1] * conv_w[1] + hp[:, 2:] * conv_w[2] + conv_b
    gate, up = jnp.split(h, 2, axis=-1)
    return (jax.nn.gelu(gate, approximate=True) * up) @ w_down


def encoder_layer(x, g_mix_pre, g_mix_post, g_ffn_pre, g_ffn_post, w_in, attn_sink,
                  rw_mu_prev, rw_mu_next, rw_w0, rw_w2, rw_a0, rw_a2, rw_g2, rw_k_k, rw_k_a,
                  rw_r_k, rw_ln_w, rw_ln_b, w_branch_attn, w_branch_rwkv, w_out,
                  w_ffn_up, ffn_conv_w, ffn_conv_b, w_ffn_down):
    B, T, _ = x.shape
    u = rms_norm(x, g_mix_pre)
    proj = u @ w_in
    c1 = ATT_W; c2 = c1 + ATT_KV_W; c3 = c2 + ATT_KV_W; c4 = c3 + RW_MIX_W
    q, k, v, z, gates = jnp.split(proj, [c1, c2, c3, c4], axis=-1)
    q = q.reshape(B, T, ATT_KV, ATT_G, ATT_HD)
    k = k.reshape(B, T, ATT_KV, ATT_HD)
    v = v.reshape(B, T, ATT_KV, ATT_HD)
    o_attn = banded_gqa_alibi_sink(q, k, v, attn_sink)
    o_rwkv = rwkv7_bidir(z, rw_mu_prev, rw_mu_next, rw_w0, rw_w2, rw_a0, rw_a2, rw_g2,
                         rw_k_k, rw_k_a, rw_r_k, rw_ln_w, rw_ln_b).astype(x.dtype)
    g_attn, g_rwkv = jnp.split(jax.nn.sigmoid(gates), 2, axis=-1)
    merged = g_attn * (o_attn @ w_branch_attn) + g_rwkv * (o_rwkv @ w_branch_rwkv)
    h = x + rms_norm(merged @ w_out, g_mix_post)
    f = conv_glu_ffn(rms_norm(h, g_ffn_pre), w_ffn_up, ffn_conv_w, ffn_conv_b, w_ffn_down)
    return h + rms_norm(f, g_ffn_post)


def setup_inputs(seed: int = 0) -> dict:
    key = jax.random.key(seed)
    ks = jax.random.split(key, 32)
    L = DEPTH
    f32 = jnp.float32

    def nrm(k, shape, scale):
        return jax.random.normal(k, shape, f32) * scale

    def unif(k, shape, lo, hi):
        return jax.random.uniform(k, shape, f32, minval=lo, maxval=hi)

    return {
        "x_prompt": nrm(ks[0], (BATCH, SEQ, D_MODEL), 1.0),
        "x_sample": nrm(ks[1], (DEC_BATCH, DEC_SEQ, D_MODEL), 1.0),
        "norm_mix_pre": 1.0 + nrm(ks[2], (L, D_MODEL), 0.02),
        "norm_mix_post": 1.0 + nrm(ks[3], (L, D_MODEL), 0.02),
        "norm_ffn_pre": 1.0 + nrm(ks[4], (L, D_MODEL), 0.02),
        "norm_ffn_post": 1.0 + nrm(ks[5], (L, D_MODEL), 0.02),
        "w_in": nrm(ks[6], (L, D_MODEL, IN_W), D_MODEL ** -0.5),
        "attn_sink": nrm(ks[7], (L, ATT_H), 0.5),
        "rw_mu_prev": unif(ks[8], (L, RW_MIX_W), 0.0, 0.5),
        "rw_mu_next": unif(ks[9], (L, RW_MIX_W), 0.0, 0.5),
        "rw_w0": unif(ks[10], (L, 2, RW_W), -5.0, -0.5),
        "rw_w2": nrm(ks[11], (L, 2, DECAY_LORA, RW_W), 0.1),
        "rw_a0": nrm(ks[12], (L, 2, RW_W), 0.1),
        "rw_a2": nrm(ks[13], (L, 2, AAA_LORA, RW_W), 0.5 * AAA_LORA ** -0.5),
        "rw_g2": nrm(ks[14], (L, GATE_LORA, RW_W), GATE_LORA ** -0.5),
        "rw_k_k": 0.85 + nrm(ks[15], (L, RW_W), 0.02),
        "rw_k_a": 1.0 + nrm(ks[16], (L, RW_W), 0.02),
        "rw_r_k": nrm(ks[17], (L, RW_H, RW_N), 0.1),
        "rw_ln_w": 1.0 + nrm(ks[18], (L, RW_W), 0.02),
        "rw_ln_b": nrm(ks[19], (L, RW_W), 0.02),
        "w_branch_attn": nrm(ks[20], (L, ATT_W, D_MODEL), ATT_W ** -0.5),
        "w_branch_rwkv": nrm(ks[21], (L, RW_W, D_MODEL), RW_W ** -0.5),
        "w_out": nrm(ks[22], (L, D_MODEL, D_MODEL), D_MODEL ** -0.5),
        "w_ffn_up": nrm(ks[23], (L, D_MODEL, 2 * D_FF), D_MODEL ** -0.5),
        "ffn_conv_w": nrm(ks[24], (L, 3, 2 * D_FF), 3.0 ** -0.5),
        "ffn_conv_b": nrm(ks[25], (L, 2 * D_FF), 0.02),
        "w_ffn_down": nrm(ks[26], (L, D_FF, D_MODEL), D_FF ** -0.5),
    }


def reference(x_prompt, x_sample, norm_mix_pre, norm_mix_post, norm_ffn_pre, norm_ffn_post,
              w_in, attn_sink, rw_mu_prev, rw_mu_next, rw_w0, rw_w2, rw_a0, rw_a2, rw_g2,
              rw_k_k, rw_k_a, rw_r_k, rw_ln_w, rw_ln_b, w_branch_attn, w_branch_rwkv, w_out,
              w_ffn_up, ffn_conv_w, ffn_conv_b, w_ffn_down):
    def run(x):
        h = x
        for l in range(DEPTH):
            h = encoder_layer(h, norm_mix_pre[l], norm_mix_post[l], norm_ffn_pre[l], norm_ffn_post[l],
                              w_in[l], attn_sink[l], rw_mu_prev[l], rw_mu_next[l], rw_w0[l], rw_w2[l],
                              rw_a0[l], rw_a2[l], rw_g2[l], rw_k_k[l], rw_k_a[l], rw_r_k[l],
                              rw_ln_w[l], rw_ln_b[l], w_branch_attn[l], w_branch_rwkv[l], w_out[l],
                              w_ffn_up[l], ffn_conv_w[l], ffn_conv_b[l], w_ffn_down[l])
        return h

    y_prompt = run(x_prompt)
    y_sample = run(x_sample)
    return (y_prompt, y_sample)
```

```cpp
#include <hip/hip_runtime.h>
#include <hip/hip_cooperative_groups.h>
#include <cstdint>
#include <cstdio>
namespace cg = cooperative_groups;

#ifndef NAIVE_GEMM
#define NAIVE_GEMM 0
#endif
#ifndef NAIVE_TR
#define NAIVE_TR 0
#endif
#ifndef DUP_MASK
#define DUP_MASK 0
#endif
#ifndef COOP_MODE
#define COOP_MODE 1
#endif

typedef unsigned short bf16_t;
typedef short bf16x8 __attribute__((ext_vector_type(8)));
typedef short s16x4 __attribute__((ext_vector_type(4)));
typedef float f32x4 __attribute__((ext_vector_type(4)));
typedef float f32x2 __attribute__((ext_vector_type(2)));
typedef unsigned u32x4 __attribute__((ext_vector_type(4)));
typedef unsigned u32x2 __attribute__((ext_vector_type(2)));
typedef __bf16 bf16x2_t __attribute__((ext_vector_type(2)));
#define DI __device__ __forceinline__

constexpr int M_TOK = 81920, DM = 1024, T_P = 16384, T_S = 2048;
constexpr int IN_W = 4768, RWW = 512, DFF = 2816, ZW = 1952, ZLD = 2048, LINW = 416, QKVW = 768, SGW = 2048;
constexpr int HALF_ROWS = 40960;
constexpr int NTHR = 512, NWV = NTHR / 64;
constexpr size_t MBY = 1ull << 20;
constexpr size_t OFF_WZT = 0, OFF_WQGT = 4 * MBY, OFF_WAT = OFF_WQGT + 2816ull * 1024 * 2, OFF_WBT = OFF_WAT + MBY, OFF_WOT = OFF_WBT + MBY,
                 OFF_WUPT = OFF_WOT + 2 * MBY, OFF_WDNT = OFF_WUPT + 11 * MBY, OFF_W2T = 30 * MBY, OFF_A2T = OFF_W2T + 128 * 1024,
                 OFF_G2T = OFF_A2T + 128 * 1024;
constexpr size_t OFF_RSTDX = 32 * MBY, OFF_RSTDH = 33 * MBY;
constexpr size_t OFF_XB = 34 * MBY;
constexpr size_t OFF_R = 194 * MBY, OFF_V = 274 * MBY, OFF_NKK = 354 * MBY, OFF_BF = 434 * MBY  ;
constexpr size_t OFF_KSH = 594 * MBY, OFF_LIN = 674 * MBY, OFF_G = 739 * MBY, OFF_YS = 819 * MBY  ;
constexpr size_t OFF_ORW = OFF_KSH;
constexpr size_t OFF_QKV = 194 * MBY, OFF_OATT = 314 * MBY, OFF_MERGED = 394 * MBY, OFF_SG = 674 * MBY  ;
constexpr size_t OFF_MO = OFF_XB, OFF_HB = 194 * MBY, OFF_HUP = 354 * MBY  , OFF_ACT = 794 * MBY  , OFF_ACT1 = 34 * MBY  , OFF_F = 354 * MBY  ;
constexpr size_t SEG = (size_t)M_TOK * 512 * 2;

struct Params { const float* in[27]; float* out; unsigned char* ws; };

DI unsigned pk2(float lo, float hi) { f32x2 v = {lo, hi}; bf16x2_t b = __builtin_convertvector(v, bf16x2_t); return __builtin_bit_cast(unsigned, b); }
DI float lo2f(unsigned u) { return __uint_as_float(u << 16); }
DI float hi2f(unsigned u) { return __uint_as_float(u & 0xffff0000u); }
DI float bf2f(bf16_t v) { return __uint_as_float(((unsigned)v) << 16); }
DI void unpack8(const u32x4 u, float* f) { f[0] = lo2f(u.x); f[1] = hi2f(u.x); f[2] = lo2f(u.y); f[3] = hi2f(u.y); f[4] = lo2f(u.z); f[5] = hi2f(u.z); f[6] = lo2f(u.w); f[7] = hi2f(u.w); }
DI u32x4 pack8(const float* f) { u32x4 u; u.x = pk2(f[0], f[1]); u.y = pk2(f[2], f[3]); u.z = pk2(f[4], f[5]); u.w = pk2(f[6], f[7]); return u; }
DI float sigmoidf_(float x) { return 1.f / (1.f + __expf(-x)); }
DI float wave_sum(float v) {
#pragma unroll
  for (int o = 32; o >= 1; o >>= 1) v += __shfl_xor(v, o);
  return v;
}
DI void seq_of(int row, int& start, int& T) { if (row < T_P) { start = 0; T = T_P; } else { start = T_P + ((row - T_P) / T_S) * T_S; T = T_S; } }

DI void transpose_job(const float* __restrict__ src, int srcN, int K, int n0, int ncols, int ncols_pad, bf16_t* __restrict__ dst,
                              const float* __restrict__ scale, float* lds) {
  const int ntn = (ncols_pad + 63) / 64, ntk = (K + 63) / 64, tid = threadIdx.x;
  if (NAIVE_TR) {
    for (size_t idx = (size_t)blockIdx.x * NTHR + tid; idx < (size_t)ncols_pad * K; idx += (size_t)gridDim.x * NTHR) {
      const int n = (int)(idx / K), k = (int)(idx % K);
      float v = 0.f;
      if (n < ncols) { v = src[(size_t)k * srcN + n0 + n]; if (scale) v *= scale[k]; }
      dst[idx] = (bf16_t)(pk2(v, 0.f) & 0xffffu);
    }
    return;
  }
  for (int t = blockIdx.x; t < ntn * ntk; t += gridDim.x) {
    const int tk = t % ntk, tn = t / ntk;
#pragma unroll
    for (int i = 0; i < 64 / NWV; ++i) {
      const int kk = i * NWV + (tid >> 6), nn = tid & 63, k = tk * 64 + kk, n = tn * 64 + nn;
      float v = 0.f;
      if (k < K && n < ncols) { v = src[(size_t)k * srcN + n0 + n]; if (scale) v *= scale[k]; }
      lds[kk * 65 + nn] = v;
    }
    __syncthreads();
#pragma unroll
    for (int i = 0; i < 64 / NWV; ++i) {
      const int nn = i * NWV + (tid >> 6), kk = tid & 63, k = tk * 64 + kk, n = tn * 64 + nn;
      if (k < K && n < ncols_pad) { unsigned u = pk2(lds[kk * 65 + nn], 0.f); dst[(size_t)n * K + k] = (bf16_t)(u & 0xffffu); }
    }
    __syncthreads();
  }
}

DI void phase_prep(const Params& p, unsigned char* ldsb) {
  float* lds = (float*)ldsb;
  unsigned char* ws = p.ws;
  transpose_job(p.in[6], IN_W, 1024, 768, ZW, ZLD, (bf16_t*)(ws + OFF_WZT), p.in[2], lds);
  transpose_job(p.in[6], IN_W, 1024, 0, 768, 768, (bf16_t*)(ws + OFF_WQGT), p.in[2], lds);
  transpose_job(p.in[6], IN_W, 1024, 2720, 2048, 2048, (bf16_t*)(ws + OFF_WQGT) + 768 * 1024, p.in[2], lds);
  transpose_job(p.in[20], 1024, 512, 0, 1024, 1024, (bf16_t*)(ws + OFF_WAT), nullptr, lds);
  transpose_job(p.in[21], 1024, 512, 0, 1024, 1024, (bf16_t*)(ws + OFF_WBT), nullptr, lds);
  transpose_job(p.in[22], 1024, 1024, 0, 1024, 1024, (bf16_t*)(ws + OFF_WOT), nullptr, lds);
  transpose_job(p.in[23], 2 * DFF, 1024, 0, 2 * DFF, 2 * DFF, (bf16_t*)(ws + OFF_WUPT), p.in[4], lds);
  transpose_job(p.in[26], 1024, DFF, 0, 1024, 1024, (bf16_t*)(ws + OFF_WDNT), nullptr, lds);
  for (int d = 0; d < 2; ++d) {
    transpose_job(p.in[11] + d * 64 * 512, 512, 64, 0, 512, 512, (bf16_t*)(ws + OFF_W2T) + d * 512 * 64, nullptr, lds);
    transpose_job(p.in[13] + d * 64 * 512, 512, 64, 0, 512, 512, (bf16_t*)(ws + OFF_A2T) + d * 512 * 64, nullptr, lds);
  }
  transpose_job(p.in[14], 512, 160, 0, 512, 512, (bf16_t*)(ws + OFF_G2T), nullptr, lds);
  const int lane = threadIdx.x & 63, gw = blockIdx.x * NWV + (threadIdx.x >> 6), nw = gridDim.x * NWV;
  bf16_t* xb = (bf16_t*)(ws + OFF_XB);
  float* rstd = (float*)(ws + OFF_RSTDX);
  for (int row = gw; row < M_TOK; row += nw) {
    const float* src = row < T_P ? p.in[0] + (size_t)row * DM : p.in[1] + (size_t)(row - T_P) * DM;
    float ss = 0.f;
#pragma unroll
    for (int i = 0; i < 4; ++i) {
      const int c = (i * 64 + lane) * 4;
      const f32x4 v = *(const f32x4*)(src + c);
      ss += v.x * v.x + v.y * v.y + v.z * v.z + v.w * v.w;
      u32x2 o; o.x = pk2(v.x, v.y); o.y = pk2(v.z, v.w);
      *(u32x2*)(xb + (size_t)row * DM + c) = o;
    }
    ss = wave_sum(ss);
    if (lane == 0) rstd[row] = rsqrtf(ss * (1.f / DM) + 1e-6f);
  }
}

constexpr int LROW = 80;
template <int MT, int NT, class Epi>
DI void gemm_tile(const bf16_t* __restrict__ A, int lda, const bf16_t* __restrict__ Bt, int ldb, int K, int row0, int col0,
                  unsigned char* lds, Epi& epi) {
  constexpr int BM = 32 * MT, BN = 32 * NT, STAGE = (BM + BN) * LROW, ACH = BM * 4 / 256, BCH = BN * 4 / 256;
  const int tid = threadIdx.x, lane = tid & 63, wid = tid >> 6, wm = wid >> 1, wn = wid & 1, fr = lane & 15, fq = lane >> 4;
  f32x4 acc[MT][NT];
#pragma unroll
  for (int i = 0; i < MT; ++i)
#pragma unroll
    for (int j = 0; j < NT; ++j) acc[i][j] = (f32x4){0.f, 0.f, 0.f, 0.f};
  u32x4 ra[ACH], rb[BCH];
  const bf16_t* ap[ACH]; const bf16_t* bp[BCH];
#pragma unroll
  for (int i = 0; i < ACH; ++i) { const int c = tid + i * 256; ap[i] = A + (size_t)(row0 + (c >> 2)) * lda + (c & 3) * 8; }
#pragma unroll
  for (int i = 0; i < BCH; ++i) { const int c = tid + i * 256; bp[i] = Bt + (size_t)(col0 + (c >> 2)) * ldb + (c & 3) * 8; }
  const int nk = K / 32;
#pragma unroll
  for (int i = 0; i < ACH; ++i) ra[i] = *(const u32x4*)(ap[i]);
#pragma unroll
  for (int i = 0; i < BCH; ++i) rb[i] = *(const u32x4*)(bp[i]);
#pragma unroll
  for (int i = 0; i < ACH; ++i) { const int c = tid + i * 256; *(u32x4*)(lds + (c >> 2) * LROW + (c & 3) * 16) = ra[i]; }
#pragma unroll
  for (int i = 0; i < BCH; ++i) { const int c = tid + i * 256; *(u32x4*)(lds + BM * LROW + (c >> 2) * LROW + (c & 3) * 16) = rb[i]; }
  __syncthreads();
  for (int kt = 0; kt < nk; ++kt) {
    const bool more = kt + 1 < nk;
    if (more) {
#pragma unroll
      for (int i = 0; i < ACH; ++i) ra[i] = *(const u32x4*)(ap[i] + (kt + 1) * 32);
#pragma unroll
      for (int i = 0; i < BCH; ++i) rb[i] = *(const u32x4*)(bp[i] + (kt + 1) * 32);
    }
    const unsigned char* sa = lds + (kt & 1) * STAGE;
    const unsigned char* sb = sa + BM * LROW;
    bf16x8 af[MT], bfv[NT];
#pragma unroll
    for (int i = 0; i < MT; ++i) af[i] = *(const bf16x8*)(sa + (wm * MT * 16 + i * 16 + fr) * LROW + fq * 16);
#pragma unroll
    for (int j = 0; j < NT; ++j) bfv[j] = *(const bf16x8*)(sb + (wn * NT * 16 + j * 16 + fr) * LROW + fq * 16);
#pragma unroll
    for (int i = 0; i < MT; ++i)
#pragma unroll
      for (int j = 0; j < NT; ++j) acc[i][j] = __builtin_amdgcn_mfma_f32_16x16x32_bf16(bfv[j], af[i], acc[i][j], 0, 0, 0);
    if (more) {
      unsigned char* da = lds + ((kt + 1) & 1) * STAGE;
#pragma unroll
      for (int i = 0; i < ACH; ++i) { const int c = tid + i * 256; *(u32x4*)(da + (c >> 2) * LROW + (c & 3) * 16) = ra[i]; }
#pragma unroll
      for (int i = 0; i < BCH; ++i) { const int c = tid + i * 256; *(u32x4*)(da + BM * LROW + (c >> 2) * LROW + (c & 3) * 16) = rb[i]; }
    }
    __syncthreads();
  }
#pragma unroll
  for (int i = 0; i < MT; ++i)
#pragma unroll
    for (int j = 0; j < NT; ++j) epi(row0 + wm * MT * 16 + i * 16 + fr, col0 + wn * NT * 16 + j * 16 + fq * 4, acc[i][j]);
}


#ifndef NAIVE_GEMM
#define NAIVE_GEMM 0
#endif
#ifndef NAIVE_TR
#define NAIVE_TR 0
#endif
template <int MT, int NT, class Epi>
DI void gemm_tile_naive(const bf16_t* A, int lda, const bf16_t* Bt, int ldb, int K, int row0, int col0, Epi& epi) {
  const int tid = threadIdx.x, lane = tid & 63, wid = tid >> 6, wm = wid >> 1, wn = wid & 1, fr = lane & 15, fq = lane >> 4;
  for (int i = 0; i < MT; ++i)
    for (int j = 0; j < NT; ++j) {
      const int row = row0 + wm * MT * 16 + i * 16 + fr, col = col0 + wn * NT * 16 + j * 16 + fq * 4;
      f32x4 acc = {0.f, 0.f, 0.f, 0.f};
      for (int k = 0; k < K; k += 8) {
        float a[8]; unpack8(*(const u32x4*)(A + (size_t)row * lda + k), a);
#pragma unroll
        for (int jj = 0; jj < 4; ++jj) { float b[8]; unpack8(*(const u32x4*)(Bt + (size_t)(col + jj) * ldb + k), b);
#pragma unroll
          for (int e = 0; e < 8; ++e) acc[jj] += a[e] * b[e]; }
      }
      epi(row, col, acc);
    }
}
DI void store4(bf16_t* ptr, f32x4 v) { u32x2 o; o.x = pk2(v.x, v.y); o.y = pk2(v.z, v.w); *(u32x2*)ptr = o; }
DI f32x4 load4(const bf16_t* ptr) { const u32x2 u = *(const u32x2*)ptr; return (f32x4){lo2f(u.x), hi2f(u.x), lo2f(u.y), hi2f(u.y)}; }

constexpr int GMT = 8, GNT = 4, GBM = 32 * GMT, GBN = 32 * GNT;

struct EpiScaleStore { bf16_t* O; int ldo; const float* rstd; int rowoff;
  DI void operator()(int row, int col, f32x4 v) { const float s = rstd[row]; store4(O + (size_t)(row - rowoff) * ldo + col, v * s); } };
struct EpiQG { bf16_t* qkv; bf16_t* sg; const float* rstd;
  DI void operator()(int row, int col, f32x4 v) { const float s = rstd[row]; v = v * s;
    if (col < QKVW) store4(qkv + (size_t)row * QKVW + col, v);
    else { f32x4 g = {sigmoidf_(v.x), sigmoidf_(v.y), sigmoidf_(v.z), sigmoidf_(v.w)}; store4(sg + (size_t)row * SGW + (col - QKVW), g); } } };
struct EpiW { bf16_t* O; const float* w0;
  DI void operator()(int row, int col, f32x4 v) { f32x4 o;
#pragma unroll
    for (int j = 0; j < 4; ++j) { const float x = w0[col + j] + v[j]; const float sp = fmaxf(-x, 0.f) + __logf(1.f + __expf(-fabsf(x)));
      const float e = __expf(-sp - 0.5f); o[j] = 1.f - __expf(-e); }
    store4(O + (size_t)row * RWW + col, o); } };
struct EpiA { bf16_t* KO; bf16_t* BO; const bf16_t* ksh; const bf16_t* nkk; const float* a0; const float* k_a;
  DI void operator()(int row, int col, f32x4 v) { const f32x4 k = load4(ksh + (size_t)row * RWW + col), nk = load4(nkk + (size_t)row * RWW + col); f32x4 ko, bo;
#pragma unroll
    for (int j = 0; j < 4; ++j) { const float a = sigmoidf_(a0[col + j] + v[j]); ko[j] = k[j] * (1.f + (a - 1.f) * k_a[col + j]); bo[j] = -nk[j] * a; }
    store4(KO + (size_t)row * RWW + col, ko); store4(BO + (size_t)row * RWW + col, bo); } };
struct EpiStore { bf16_t* O; int ldo;
  DI void operator()(int row, int col, f32x4 v) { store4(O + (size_t)row * ldo + col, v); } };
struct EpiMerge1 { bf16_t* O; const bf16_t* sg;
  DI void operator()(int row, int col, f32x4 v) { const f32x4 g = load4(sg + (size_t)row * SGW + col); store4(O + (size_t)row * DM + col, v * g); } };
struct EpiMerge2 { bf16_t* O; const bf16_t* sg;
  DI void operator()(int row, int col, f32x4 v) { const f32x4 g = load4(sg + (size_t)row * SGW + 1024 + col); bf16_t* o = O + (size_t)row * DM + col; const f32x4 prev = load4(o); store4(o, prev + v * g); } };

constexpr int LROW8 = 144, T8 = 256, STAGE8 = 2 * T8 * LROW8;
template <class Epi>
DI void gemm_tile8(const bf16_t* __restrict__ A, int lda, const bf16_t* __restrict__ Bt, int ldb, int K, int row0, int col0,
                   unsigned char* lds, Epi& epi) {
  const int tid = threadIdx.x, lane = tid & 63, wid = tid >> 6, wm = wid >> 2, wn = wid & 3, fr = lane & 15, fq = lane >> 4;
  f32x4 acc[8][4];
#pragma unroll
  for (int i = 0; i < 8; ++i)
#pragma unroll
    for (int j = 0; j < 4; ++j) acc[i][j] = (f32x4){0.f, 0.f, 0.f, 0.f};
  u32x4 ra[4], rb[4];
  const int lrow = tid >> 3, lkc = tid & 7;
  const bf16_t* ap = A + (size_t)(row0 + lrow) * lda + lkc * 8;
  const bf16_t* bp = Bt + (size_t)(col0 + lrow) * ldb + lkc * 8;
  const size_t astep = (size_t)64 * lda, bstep = (size_t)64 * ldb;
  unsigned char* wa = lds + lrow * LROW8 + lkc * 16;
  const int nk = K / 64, krem = K & 63;
#pragma unroll
  for (int i = 0; i < 4; ++i) ra[i] = *(const u32x4*)(ap + i * astep);
#pragma unroll
  for (int i = 0; i < 4; ++i) rb[i] = *(const u32x4*)(bp + i * bstep);
#pragma unroll
  for (int i = 0; i < 4; ++i) *(u32x4*)(wa + i * 64 * LROW8) = ra[i];
#pragma unroll
  for (int i = 0; i < 4; ++i) *(u32x4*)(wa + T8 * LROW8 + i * 64 * LROW8) = rb[i];
  __syncthreads();
  const int nkt = nk + (krem ? 1 : 0);
  for (int kt = 0; kt < nkt; ++kt) {
    const bool more = kt + 1 < nkt;
    const unsigned char* sa = lds + (kt & 1) * STAGE8 + (wm * 128 + fr) * LROW8 + fq * 16;
    const unsigned char* sb = lds + (kt & 1) * STAGE8 + T8 * LROW8 + (wn * 64 + fr) * LROW8 + fq * 16;
    const int nsub = (kt == nk) ? 1 : 2;
#pragma unroll
    for (int ks = 0; ks < 2; ++ks) {
      if (ks < nsub) {
        bf16x8 bfv[4];
#pragma unroll
        for (int j = 0; j < 4; ++j) bfv[j] = *(const bf16x8*)(sb + j * 16 * LROW8 + ks * 64);
#pragma unroll
        for (int ih = 0; ih < 2; ++ih) {
          bf16x8 af[4];
#pragma unroll
          for (int i = 0; i < 4; ++i) af[i] = *(const bf16x8*)(sa + (ih * 4 + i) * 16 * LROW8 + ks * 64);
#pragma unroll
          for (int i = 0; i < 4; ++i) {
#pragma unroll
            for (int j = 0; j < 4; ++j) acc[ih * 4 + i][j] = __builtin_amdgcn_mfma_f32_16x16x32_bf16(bfv[j], af[i], acc[ih * 4 + i][j], 0, 0, 0);
            if (ks == 0 && i == 1) {
              asm volatile("" ::: "memory");
              if (more) {
                const int koff = (kt + 1) * 64 - ((kt + 1 == nk && krem && lkc >= 4) ? 32 : 0);
                if (ih == 0) {
#pragma unroll
                  for (int q = 0; q < 4; ++q) ra[q] = *(const u32x4*)(ap + q * astep + koff);
                } else {
#pragma unroll
                  for (int q = 0; q < 4; ++q) rb[q] = *(const u32x4*)(bp + q * bstep + koff);
                }
              }
              asm volatile("" ::: "memory");
            }
          }
        }
      }
    }
    if (more) {
      unsigned char* da = wa + ((kt + 1) & 1) * STAGE8;
#pragma unroll
      for (int i = 0; i < 4; ++i) *(u32x4*)(da + i * 64 * LROW8) = ra[i];
#pragma unroll
      for (int i = 0; i < 4; ++i) *(u32x4*)(da + T8 * LROW8 + i * 64 * LROW8) = rb[i];
    }
    __syncthreads();
  }
#pragma unroll
  for (int i = 0; i < 8; ++i)
#pragma unroll
    for (int j = 0; j < 4; ++j) epi(row0 + wm * 128 + i * 16 + fr, col0 + wn * 64 + j * 16 + fq * 4, acc[i][j]);
}

DI void tile_of(int t, int ntm, int ntn, int& tm, int& tn) {
  const int G = gridDim.x;
  if ((G & 7) == 0 && (ntm & 31) == 0) {
    const int x = t & 7, l = (t >> 3), mper = ntm >> 3;
    const int gs = (mper & 7) == 0 ? 8 : 4;
    const int grp = l / (gs * ntn), r = l % (gs * ntn);
    tm = x * mper + grp * gs + (r % gs); tn = r / gs;
  } else { tm = t / ntn; tn = t % ntn; }
}
template <int MT = 0, class Epi>
DI void gemm_phase(const bf16_t* A, int lda, const bf16_t* Bt, int ldb, int K, int rows0, int nrows, int N, unsigned char* lds, Epi& epi, int rot = 0) {
  const int ntn = N / T8, ntm = nrows / T8;
  for (int t = (int)((blockIdx.x + rot) % gridDim.x); t < ntn * ntm; t += gridDim.x) {
    int tm, tn; tile_of(t, ntm, ntn, tm, tn);
    gemm_tile8(A, lda, Bt, ldb, K, rows0 + tm * T8, tn * T8, lds, epi);
  }
}

DI void phase_rwprep(const Params& p) {
  unsigned char* ws = p.ws;
  const bf16_t* z = (const bf16_t*)p.out;
  bf16_t* R = (bf16_t*)(ws + OFF_R); bf16_t* V = (bf16_t*)(ws + OFF_V); bf16_t* NKK = (bf16_t*)(ws + OFF_NKK);
  bf16_t* KSH = (bf16_t*)(ws + OFF_KSH); bf16_t* LIN = (bf16_t*)(ws + OFF_LIN);
  const float* mup = p.in[8]; const float* mun = p.in[9]; const float* k_k = p.in[15];
  const int lane = threadIdx.x & 63, gw = blockIdx.x * NWV + (threadIdx.x >> 6), nw = gridDim.x * NWV;
  constexpr int RB = 8;
  for (int rbk = gw; rbk < M_TOK / RB; rbk += nw) {
    const int row0 = rbk * RB;
    int start, T; seq_of(row0, start, T);
    const int pos0 = row0 - start;
#pragma unroll
    for (int seg = 0; seg < 4; ++seg) {
      const int c = seg < 3 ? seg * 512 + lane * 8 : 1536 + lane * 8;
      if (seg == 3 && lane >= 52) break;
      float mp[8], mn[8], kkw[8];
#pragma unroll
      for (int e = 0; e < 8; ++e) { mp[e] = mup[c + e]; mn[e] = mun[c + e]; kkw[e] = seg == 1 ? k_k[lane * 8 + e] : 0.f; }
      const bf16_t* zr = z + (size_t)row0 * ZLD + c;
      float zp[8], zc[8], zn[8], zs[8];
      if (pos0 > 0) unpack8(*(const u32x4*)(zr - ZLD), zp); else { for (int e = 0; e < 8; ++e) zp[e] = 0.f; }
      unpack8(*(const u32x4*)zr, zc);
#pragma unroll
      for (int r = 0; r < RB; ++r) {
        const int row = row0 + r;
        if (pos0 + r < T - 1) unpack8(*(const u32x4*)(zr + (size_t)(r + 1) * ZLD), zn); else { for (int e = 0; e < 8; ++e) zn[e] = 0.f; }
#pragma unroll
        for (int e = 0; e < 8; ++e) zs[e] = zc[e] + mp[e] * (zp[e] - zc[e]) + mn[e] * (zn[e] - zc[e]);
        if (seg == 0) *(u32x4*)(R + (size_t)row * RWW + lane * 8) = pack8(zs);
        else if (seg == 2) *(u32x4*)(V + (size_t)row * RWW + lane * 8) = pack8(zs);
        else if (seg == 1) {
          *(u32x4*)(KSH + (size_t)row * RWW + lane * 8) = pack8(zs);
          float kk[8], ss = 0.f;
#pragma unroll
          for (int e = 0; e < 8; ++e) { kk[e] = zs[e] * kkw[e]; ss += kk[e] * kk[e]; }
          ss += __shfl_xor(ss, 1); ss += __shfl_xor(ss, 2); ss += __shfl_xor(ss, 4);
          const float inv = -1.f / fmaxf(sqrtf(ss), 1e-12f);
#pragma unroll
          for (int e = 0; e < 8; ++e) kk[e] *= inv;
          *(u32x4*)(NKK + (size_t)row * RWW + lane * 8) = pack8(kk);
        } else {
#pragma unroll
          for (int e = 0; e < 8; ++e) {
            if (lane < 16) { const float t2 = __expf(2.f * zs[e]); zs[e] = 1.f - 2.f / (t2 + 1.f); }
            else if (lane >= 32) zs[e] = sigmoidf_(zs[e]);
          }
          *(u32x4*)(LIN + (size_t)row * LINW + lane * 8) = pack8(zs);
        }
#pragma unroll
        for (int e = 0; e < 8; ++e) { zp[e] = zc[e]; zc[e] = zn[e]; }
      }
    }
  }
}

DI float dpp_xor1(float v) { return __builtin_bit_cast(float, __builtin_amdgcn_update_dpp(0, __builtin_bit_cast(int, v), 0xB1, 0xF, 0xF, false)); }
DI float dpp_xor2(float v) { return __builtin_bit_cast(float, __builtin_amdgcn_update_dpp(0, __builtin_bit_cast(int, v), 0x4E, 0xF, 0xF, false)); }
struct ScanRaw { u32x4 r[2], w[2], k[2], a[2], b[2]; u32x2 v; };
DI void unpack16_2(const u32x4* u, f32x2* f) {
#pragma unroll
  for (int i = 0; i < 2; ++i) { f[i * 4 + 0] = (f32x2){lo2f(u[i].x), hi2f(u[i].x)}; f[i * 4 + 1] = (f32x2){lo2f(u[i].y), hi2f(u[i].y)};
    f[i * 4 + 2] = (f32x2){lo2f(u[i].z), hi2f(u[i].z)}; f[i * 4 + 3] = (f32x2){lo2f(u[i].w), hi2f(u[i].w)}; }
}
constexpr int NCH = 8, CHL = T_P / NCH;
constexpr size_t OFF_QB = 979 * MBY  , OFF_ST = 1011 * MBY  ;
constexpr int SCAN_TS = 8, SCAN_WLDS = SCAN_TS * 6 * 64 * 4;
DI void phase_scan(const Params& p, unsigned char* ldsb) {
  unsigned char* ws = p.ws;
  const bf16_t* R = (const bf16_t*)(ws + OFF_R); const bf16_t* V = (const bf16_t*)(ws + OFF_V); const bf16_t* NKK = (const bf16_t*)(ws + OFF_NKK);
  const int wid = threadIdx.x >> 6, lane = threadIdx.x & 63, rg = lane >> 2, cgp = lane & 3;
  float* L = (float*)(ldsb + wid * SCAN_WLDS);
  const int sst = lane >> 3, sch = lane & 7;
  constexpr int NCHAIN = 32 * 16 + NCH * 16 * 2;
  for (int chain = blockIdx.x * 3 + wid; wid < 3 && chain < NCHAIN; chain += 3 * gridDim.x) {
    int hd, start, T, i0, mode, cidx = 0;
    if (chain < 512) { hd = chain & 15; start = T_P + (chain >> 4) * T_S; T = T_S; i0 = 0; mode = 0; }
    else { const int pc = chain - 512; mode = pc & 1; hd = (pc >> 1) & 15; cidx = pc >> 5; start = 0; T = T_P; i0 = cidx * CHL; }
    const int h = hd >> 1, d = hd & 1;
    const bf16_t* Wd = (const bf16_t*)((const unsigned char*)p.out + (size_t)d * SEG);
    const bf16_t* Kd = (const bf16_t*)((const unsigned char*)p.out + (size_t)(2 + d) * SEG);
    const bf16_t* Bd = (const bf16_t*)(ws + OFF_BF + (size_t)d * SEG);
    bf16_t* YS = mode ? (bf16_t*)(ws + OFF_QB + (size_t)d * T_P * RWW * 2) : (bf16_t*)(ws + OFF_YS + (size_t)d * SEG);
    const int rb = h * 64 + rg * 4;
    f32x2 S[4][8];
#pragma unroll
    for (int r = 0; r < 4; ++r)
#pragma unroll
      for (int c = 0; c < 8; ++c) {
        const int row = rg * 4 + r, col = cgp * 16 + 2 * c;
        S[r][c] = (f32x2){(mode && row == col) ? 1.f : 0.f, (mode && row == col + 1) ? 1.f : 0.f};
      }
    u32x4 g[6];
    auto gload = [&](int ic) {
      const int i = ic + sst, t = d ? T - 1 - i : i; const size_t o = (size_t)(start + t) * RWW + h * 64 + sch * 8;
      g[0] = *(const u32x4*)(NKK + o); g[1] = *(const u32x4*)(Wd + o); g[2] = *(const u32x4*)(Bd + o);
      g[3] = *(const u32x4*)(Kd + o); g[4] = *(const u32x4*)(R + o); g[5] = *(const u32x4*)(V + o);
    };
    auto lwrite = [&]() {
#pragma unroll
      for (int x = 0; x < 6; ++x) {
        float f[8]; unpack8(g[x], f);
        if (x == 1) { for (int e = 0; e < 8; ++e) f[e] = 1.f - f[e]; }
        if (x == 5 && mode) { for (int e = 0; e < 8; ++e) f[e] = 0.f; }
        float* dst = L + sst * 384 + x * 64 + sch * 8;
        *(f32x4*)dst = (f32x4){f[0], f[1], f[2], f[3]}; *(f32x4*)(dst + 4) = (f32x4){f[4], f[5], f[6], f[7]};
      }
    };
    gload(i0); lwrite();
    const int iend = i0 + T_S;
#pragma unroll 1
    for (int ic = i0; ic < iend; ic += SCAN_TS) {
      const bool more = ic + SCAN_TS < iend;
      if (more) gload(ic + SCAN_TS);
#pragma unroll
      for (int s = 0; s < SCAN_TS; ++s) {
        const float* Ls = L + s * 384;
        const f32x4 vq = *(const f32x4*)(Ls + 5 * 64 + rg * 4);
        const float vv[4] = {vq.x, vq.y, vq.z, vq.w};
        f32x2 sa2[4], y2[4];
        {
          f32x2 aa[8];
#pragma unroll
          for (int q = 0; q < 4; ++q) { const f32x4 t4 = *(const f32x4*)(Ls + 0 * 64 + cgp * 16 + q * 4); aa[2 * q] = (f32x2){t4.x, t4.y}; aa[2 * q + 1] = (f32x2){t4.z, t4.w}; }
#pragma unroll
          for (int r = 0; r < 4; ++r) {
            f32x2 s2 = S[r][0] * aa[0];
#pragma unroll
            for (int c = 1; c < 8; ++c) s2 += S[r][c] * aa[c];
            float sa = s2.x + s2.y;
            sa += dpp_xor1(sa); sa += dpp_xor2(sa);
            sa2[r] = (f32x2){sa, sa}; y2[r] = (f32x2){0.f, 0.f};
          }
        }
#pragma unroll
        for (int q = 0; q < 4; ++q) {
          const f32x4 w4 = *(const f32x4*)(Ls + 1 * 64 + cgp * 16 + q * 4), b4 = *(const f32x4*)(Ls + 2 * 64 + cgp * 16 + q * 4);
          const f32x4 k4 = *(const f32x4*)(Ls + 3 * 64 + cgp * 16 + q * 4), r4 = *(const f32x4*)(Ls + 4 * 64 + cgp * 16 + q * 4);
#pragma unroll
          for (int hh = 0; hh < 2; ++hh) {
            const int c = 2 * q + hh;
            const f32x2 w = hh ? (f32x2){w4.z, w4.w} : (f32x2){w4.x, w4.y}, b = hh ? (f32x2){b4.z, b4.w} : (f32x2){b4.x, b4.y};
            const f32x2 k = hh ? (f32x2){k4.z, k4.w} : (f32x2){k4.x, k4.y}, rr = hh ? (f32x2){r4.z, r4.w} : (f32x2){r4.x, r4.y};
#pragma unroll
            for (int r = 0; r < 4; ++r) {
              const f32x2 v2 = {vv[r], vv[r]};
              S[r][c] = S[r][c] * w + (sa2[r] * b + v2 * k);
              y2[r] += S[r][c] * rr;
            }
          }
        }
        float y[4];
#pragma unroll
        for (int r = 0; r < 4; ++r) { float yy = y2[r].x + y2[r].y; yy += dpp_xor1(yy); yy += dpp_xor2(yy); y[r] = yy; }
        if (cgp == 0) {
          const int i = ic + s, t = d ? T - 1 - i : i;
          u32x2 o; o.x = pk2(y[0], y[1]); o.y = pk2(y[2], y[3]);
          *(u32x2*)(YS + (size_t)(start + t) * RWW + rb) = o;
        }
      }
      if (more) lwrite();
    }
    if (chain >= 512) {
      float* st = (float*)(ws + OFF_ST) + ((size_t)(cidx * 16 + hd) * 2 + mode) * 4096;
#pragma unroll
      for (int r = 0; r < 4; ++r)
#pragma unroll
        for (int c = 0; c < 8; ++c) *(f32x2*)(st + (rg * 4 + r) * 64 + cgp * 16 + 2 * c) = S[r][c];
    }
  }
}

DI void phase_scan_fix(const Params& p, unsigned char* ldsb) {
  unsigned char* ws = p.ws;
  const int tid = threadIdx.x, lane = tid & 63, wid = tid >> 6;
  constexpr int NSUB = 2, SUBL = CHL / NSUB;
  float* SA = (float*)ldsb; float* SB = SA + 64 * 65;
  for (int item = blockIdx.x; item < (NCH - 1) * 16 * NSUB; item += gridDim.x) {
    const int c = 1 + item / (16 * NSUB), rem = item % (16 * NSUB), hd = rem / NSUB, sub = rem % NSUB, h = hd >> 1, d = hd & 1;
    const int fi = (tid & 255) >> 2, fj = (tid & 3) * 16;
    float* cur = SA; float* nxt = SB;
    __syncthreads();
    {
      const float* U0 = (const float*)(ws + OFF_ST) + ((size_t)(0 * 16 + hd) * 2 + 0) * 4096;
      if (tid < 256) {
#pragma unroll
        for (int k = 0; k < 16; ++k) cur[fi * 65 + fj + k] = U0[fi * 64 + fj + k];
      }
    }
    __syncthreads();
#pragma unroll 1
    for (int cc = 1; cc < c; ++cc) {
      const float* U = (const float*)(ws + OFF_ST) + ((size_t)(cc * 16 + hd) * 2 + 0) * 4096;
      const float* P = U + 4096;
      if (tid < 256) {
      f32x4 acc[4];
#pragma unroll
      for (int j = 0; j < 4; ++j) acc[j] = *(const f32x4*)(U + fi * 64 + fj + j * 4);
#pragma unroll 4
      for (int m = 0; m < 64; ++m) {
        const float s = cur[fi * 65 + m];
#pragma unroll
        for (int j = 0; j < 4; ++j) acc[j] += *(const f32x4*)(P + m * 64 + fj + j * 4) * s;
      }
#pragma unroll
      for (int j = 0; j < 4; ++j) { nxt[fi * 65 + fj + j * 4] = acc[j].x; nxt[fi * 65 + fj + j * 4 + 1] = acc[j].y; nxt[fi * 65 + fj + j * 4 + 2] = acc[j].z; nxt[fi * 65 + fj + j * 4 + 3] = acc[j].w; }
      }
      __syncthreads();
      float* t2 = cur; cur = nxt; nxt = t2;
    }
    float S[64];
#pragma unroll
    for (int j = 0; j < 64; ++j) S[j] = cur[lane * 65 + j];
    const bf16_t* QB = (const bf16_t*)(ws + OFF_QB + (size_t)d * T_P * RWW * 2);
    bf16_t* YS = (bf16_t*)(ws + OFF_YS + (size_t)d * SEG);
#pragma unroll 1
    for (int i = c * CHL + sub * SUBL + wid; i < c * CHL + (sub + 1) * SUBL; i += NWV) {
      const int t = d ? T_P - 1 - i : i; const size_t o = (size_t)t * RWW + h * 64;
      float corr = 0.f;
#pragma unroll
      for (int c8 = 0; c8 < 8; ++c8) { float q[8]; unpack8(*(const u32x4*)(QB + o + c8 * 8), q);
#pragma unroll
        for (int e = 0; e < 8; ++e) corr += S[c8 * 8 + e] * q[e]; }
      const float y = bf2f(YS[o + lane]) + corr;
      YS[o + lane] = (bf16_t)(pk2(y, 0.f) & 0xffffu);
    }
  }
}

DI void phase_rwfinish(const Params& p) {
  unsigned char* ws = p.ws;
  const bf16_t* YF = (const bf16_t*)(ws + OFF_YS); const bf16_t* YB = (const bf16_t*)(ws + OFF_YS + SEG);
  const bf16_t* R = (const bf16_t*)(ws + OFF_R); const bf16_t* V = (const bf16_t*)(ws + OFF_V); const bf16_t* G = (const bf16_t*)(ws + OFF_G);
  const bf16_t* KF = (const bf16_t*)((const unsigned char*)p.out + 2 * SEG); const bf16_t* KB = (const bf16_t*)((const unsigned char*)p.out + 3 * SEG);
  bf16_t* O = (bf16_t*)(ws + OFF_ORW);
  const float* r_k = p.in[17]; const float* ln_w = p.in[18]; const float* ln_b = p.in[19];
  const int lane = threadIdx.x & 63, gw = blockIdx.x * NWV + (threadIdx.x >> 6), nw = gridDim.x * NWV;
  for (int it = gw; it < M_TOK * 2; it += nw) {
    const int row = it >> 1, ch = (it & 1) * 256 + lane * 4;
    const size_t o = (size_t)row * RWW + ch;
    const f32x4 yf = load4(YF + o), yb = load4(YB + o), r = load4(R + o), kf = load4(KF + o), kb = load4(KB + o), v = load4(V + o), g = load4(G + o);
    const f32x4 y = yf + yb;
    const f32x4 rk = *(const f32x4*)(r_k + ch);
    float s = y.x + y.y + y.z + y.w;
    const f32x4 bq = r * (kf + kb) * rk;
    float bs = bq.x + bq.y + bq.z + bq.w;
#pragma unroll
    for (int m = 1; m < 16; m <<= 1) { s += __shfl_xor(s, m); bs += __shfl_xor(bs, m); }
    const float mu = s * (1.f / 64.f);
    const f32x4 dv = y - mu;
    float q = dv.x * dv.x + dv.y * dv.y + dv.z * dv.z + dv.w * dv.w;
#pragma unroll
    for (int m = 1; m < 16; m <<= 1) q += __shfl_xor(q, m);
    const float rs = rsqrtf(q * (1.f / 64.f) + 64e-5f);
    const f32x4 lw = *(const f32x4*)(ln_w + ch), lb = *(const f32x4*)(ln_b + ch);
    const f32x4 res = (dv * rs * lw + lb + v * bs) * g;
    store4(O + o, res);
  }
}

DI void phase_attn(const Params& p, unsigned char* lds) {
  unsigned char* ws = p.ws;
  const bf16_t* qkv = (const bf16_t*)(ws + OFF_QKV);
  bf16_t* oatt = (bf16_t*)(ws + OFF_OATT);
  const int tid = threadIdx.x, lane = tid & 63, wid = tid >> 6, fr = lane & 15, fq = lane >> 4;
  const int kvh = wid >> 2;
  bf16_t* KsAll = (bf16_t*)lds; bf16_t* VtAll = (bf16_t*)(lds + 9216);
  const bf16_t* Ks = KsAll + kvh * (32 * 72);
  const bf16_t* Vt = VtAll + kvh * (64 * 36);
  const int njobs = M_TOK / 32;
  for (int job = blockIdx.x; job < njobs; job += gridDim.x) {
    const int q0 = job * 32;
    int start, T; seq_of(q0, start, T);
    const int h = wid;
    const float slope = exp2f(-(float)(h + 1)), sink = p.in[7][h];
    bf16x8 qf[2][2];
#pragma unroll
    for (int mt = 0; mt < 2; ++mt)
#pragma unroll
      for (int ks = 0; ks < 2; ++ks) qf[mt][ks] = *(const bf16x8*)(qkv + (size_t)(q0 + mt * 16 + fr) * QKVW + h * 64 + ks * 32 + fq * 8);
    f32x4 o[4][2];
#pragma unroll
    for (int a = 0; a < 4; ++a)
#pragma unroll
      for (int b = 0; b < 2; ++b) o[a][b] = (f32x4){0.f, 0.f, 0.f, 0.f};
    float mrun[2], lrun[2];
#pragma unroll
    for (int mt = 0; mt < 2; ++mt) { mrun[mt] = sink; lrun[mt] = fq == 0 ? 1.f : 0.f; }
#pragma unroll 1
    for (int kt = 0; kt < 9; ++kt) {
      const int kb = q0 - 128 + kt * 32, kbr = kb - start;
      if (kbr < 128 || kbr >= T + 128) continue;
      const bool phantom = kbr >= T;
      __syncthreads();
      {
        const int skv = tid >> 8, key = (tid & 255) >> 3, dc = tid & 7;
        const bf16_t* src = qkv + (size_t)(kb + key) * QKVW + 512 + skv * 64 + dc * 8;
        u32x4 kvv = {0u, 0u, 0u, 0u}, vv = {0u, 0u, 0u, 0u};
        if (!phantom) { kvv = *(const u32x4*)src; vv = *(const u32x4*)(src + 128); }
        bf16_t* Vw = VtAll + skv * (64 * 36);
        *(u32x4*)(KsAll + skv * (32 * 72) + key * 72 + dc * 8) = kvv;
        const unsigned w[4] = {vv.x, vv.y, vv.z, vv.w};
#pragma unroll
        for (int e = 0; e < 4; ++e) { Vw[(dc * 8 + 2 * e) * 36 + key] = (bf16_t)(w[e] & 0xffffu); Vw[(dc * 8 + 2 * e + 1) * 36 + key] = (bf16_t)(w[e] >> 16); }
      }
      __syncthreads();
#pragma unroll
      for (int mt = 0; mt < 2; ++mt) {
        f32x4 s[2];
#pragma unroll
        for (int nt = 0; nt < 2; ++nt) {
          s[nt] = (f32x4){0.f, 0.f, 0.f, 0.f};
#pragma unroll
          for (int ks = 0; ks < 2; ++ks) {
            const bf16x8 kf = *(const bf16x8*)(Ks + (nt * 16 + fr) * 72 + ks * 32 + fq * 8);
            s[nt] = __builtin_amdgcn_mfma_f32_16x16x32_bf16(kf, qf[mt][ks], s[nt], 0, 0, 0);
          }
        }
        const int tq = q0 + mt * 16 + fr;
        float mx = -1e30f;
#pragma unroll
        for (int nt = 0; nt < 2; ++nt)
#pragma unroll
          for (int j = 0; j < 4; ++j) {
            const int tk = kb + nt * 16 + fq * 4 + j; const int dist = tq > tk ? tq - tk : tk - tq;
            const float sc = dist <= 128 ? s[nt][j] * 0.125f - slope * (float)dist : -1e30f;
            s[nt][j] = sc; mx = fmaxf(mx, sc);
          }
        mx = fmaxf(mx, __shfl_xor(mx, 16)); mx = fmaxf(mx, __shfl_xor(mx, 32));
        const float mnew = fmaxf(mrun[mt], mx), alpha = __expf(mrun[mt] - mnew);
        mrun[mt] = mnew;
        float ls = 0.f;
#pragma unroll
        for (int nt = 0; nt < 2; ++nt)
#pragma unroll
          for (int j = 0; j < 4; ++j) { const float pe = __expf(s[nt][j] - mnew); s[nt][j] = pe; ls += pe; }
        lrun[mt] = lrun[mt] * alpha + ls;
#pragma unroll
        for (int dt = 0; dt < 4; ++dt) o[dt][mt] = o[dt][mt] * alpha;
        u32x4 pu; pu.x = pk2(s[0][0], s[0][1]); pu.y = pk2(s[0][2], s[0][3]); pu.z = pk2(s[1][0], s[1][1]); pu.w = pk2(s[1][2], s[1][3]);
        const bf16x8 pf = __builtin_bit_cast(bf16x8, pu);
#pragma unroll
        for (int dt = 0; dt < 4; ++dt) {
          const bf16_t* vrow = Vt + (dt * 16 + fr) * 36 + fq * 4;
          u32x4 vu; const u32x2 v0 = *(const u32x2*)(vrow), v1 = *(const u32x2*)(vrow + 16);
          vu.x = v0.x; vu.y = v0.y; vu.z = v1.x; vu.w = v1.y;
          o[dt][mt] = __builtin_amdgcn_mfma_f32_16x16x32_bf16(__builtin_bit_cast(bf16x8, vu), pf, o[dt][mt], 0, 0, 0);
        }
      }
    }
#pragma unroll
    for (int mt = 0; mt < 2; ++mt) {
      float l = lrun[mt]; l += __shfl_xor(l, 16); l += __shfl_xor(l, 32);
      const float inv = 1.f / l;
#pragma unroll
      for (int dt = 0; dt < 4; ++dt) store4(oatt + (size_t)(q0 + mt * 16 + fr) * 512 + h * 64 + dt * 16 + fq * 4, o[dt][mt] * inv);
    }
  }
}


#ifndef NAIVE_ATTN
#define NAIVE_ATTN 0
#endif
#ifndef NAIVE_SCAN
#define NAIVE_SCAN 0
#endif
DI void phase_attn_naive(const Params& p) {
  unsigned char* ws = p.ws;
  const bf16_t* qkv = (const bf16_t*)(ws + OFF_QKV);
  bf16_t* oatt = (bf16_t*)(ws + OFF_OATT);
  const int lane = threadIdx.x & 63, gw = blockIdx.x * NWV + (threadIdx.x >> 6), nw = gridDim.x * NWV;
  for (int item = gw; item < M_TOK * 8; item += nw) {
    const int row = item >> 3, h = item & 7, kvh = h >> 2;
    int start, T; seq_of(row, start, T);
    const float slope = exp2f(-(float)(h + 1)), sink = p.in[7][h];
    const float q = bf2f(qkv[(size_t)row * QKVW + h * 64 + lane]);
    const int lo = max(row - 128, start + 128), hi = min(row + 128, start + T + 127);
    float m = sink, l = 1.f, acc = 0.f;
    for (int s = lo; s <= hi; ++s) {
      const bool real = s < start + T;
      const float kx = real ? bf2f(qkv[(size_t)s * QKVW + 512 + kvh * 64 + lane]) : 0.f;
      const float vx = real ? bf2f(qkv[(size_t)s * QKVW + 640 + kvh * 64 + lane]) : 0.f;
      const int dist = row > s ? row - s : s - row;
      const float sc = wave_sum(q * kx) * 0.125f - slope * (float)dist;
      const float mnew = fmaxf(m, sc), alpha = __expf(m - mnew), pe = __expf(sc - mnew);
      l = l * alpha + pe; acc = acc * alpha + pe * vx; m = mnew;
    }
    oatt[(size_t)row * 512 + h * 64 + lane] = (bf16_t)(pk2(acc / l, 0.f) & 0xffffu);
  }
}
DI void phase_scan_naive(const Params& p) {
  unsigned char* ws = p.ws;
  const bf16_t* R = (const bf16_t*)(ws + OFF_R); const bf16_t* V = (const bf16_t*)(ws + OFF_V); const bf16_t* NKK = (const bf16_t*)(ws + OFF_NKK);
  const int wid = threadIdx.x >> 6, lane = threadIdx.x & 63;
  for (int chain = wid * gridDim.x + blockIdx.x; chain < 33 * 16; chain += 4 * gridDim.x) {
    const int seq = chain >> 4, hd = chain & 15, h = hd >> 1, d = hd & 1;
    const int start = seq == 0 ? 0 : T_P + (seq - 1) * T_S, T = seq == 0 ? T_P : T_S;
    const bf16_t* Wd = (const bf16_t*)((const unsigned char*)p.out + (size_t)d * SEG);
    const bf16_t* Kd = (const bf16_t*)((const unsigned char*)p.out + (size_t)(2 + d) * SEG);
    const bf16_t* Bd = (const bf16_t*)(ws + OFF_BF + (size_t)d * SEG);
    bf16_t* YS = (bf16_t*)(ws + OFF_YS + (size_t)d * SEG);
    float S[64];
#pragma unroll
    for (int j = 0; j < 64; ++j) S[j] = 0.f;
    for (int i = 0; i < T; ++i) {
      const int t = d ? T - 1 - i : i; const size_t o = (size_t)(start + t) * RWW + h * 64;
      const float v = bf2f(V[o + lane]);
      float sa = 0.f;
#pragma unroll
      for (int c = 0; c < 8; ++c) { float a[8]; unpack8(*(const u32x4*)(NKK + o + c * 8), a);
#pragma unroll
        for (int e = 0; e < 8; ++e) sa += S[c * 8 + e] * a[e]; }
      float y = 0.f;
#pragma unroll
      for (int c = 0; c < 8; ++c) { float w[8], k[8], b[8], r[8];
        unpack8(*(const u32x4*)(Wd + o + c * 8), w); unpack8(*(const u32x4*)(Kd + o + c * 8), k); unpack8(*(const u32x4*)(Bd + o + c * 8), b); unpack8(*(const u32x4*)(R + o + c * 8), r);
#pragma unroll
        for (int e = 0; e < 8; ++e) { const float sn = S[c * 8 + e] * (1.f - w[e]) + sa * b[e] + v * k[e]; S[c * 8 + e] = sn; y += sn * r[e]; } }
      YS[o + lane] = (bf16_t)(pk2(y, 0.f) & 0xffffu);
    }
  }
}
DI void phase_row_h(const Params& p) {
  unsigned char* ws = p.ws;
  const bf16_t* MO = (const bf16_t*)(ws + OFF_MO); bf16_t* HB = (bf16_t*)(ws + OFF_HB); float* rstdh = (float*)(ws + OFF_RSTDH);
  const float* g = p.in[3];
  const int lane = threadIdx.x & 63, gw = blockIdx.x * NWV + (threadIdx.x >> 6), nw = gridDim.x * NWV;
  for (int row = gw; row < M_TOK; row += nw) {
    const float* xs = row < T_P ? p.in[0] + (size_t)row * DM : p.in[1] + (size_t)(row - T_P) * DM;
    float m[16]; float ss = 0.f;
#pragma unroll
    for (int i = 0; i < 2; ++i) unpack8(*(const u32x4*)(MO + (size_t)row * DM + i * 512 + lane * 8), m + i * 8);
#pragma unroll
    for (int e = 0; e < 16; ++e) ss += m[e] * m[e];
    ss = wave_sum(ss);
    const float rs = rsqrtf(ss * (1.f / DM) + 1e-6f);
    float hs = 0.f; float hv[16];
#pragma unroll
    for (int i = 0; i < 2; ++i)
#pragma unroll
      for (int q = 0; q < 2; ++q) {
        const int c = i * 512 + lane * 8 + q * 4;
        const f32x4 xv = *(const f32x4*)(xs + c), gv = *(const f32x4*)(g + c);
        f32x4 hh;
#pragma unroll
        for (int e = 0; e < 4; ++e) { hh[e] = xv[e] + m[i * 8 + q * 4 + e] * rs * gv[e]; hv[i * 8 + q * 4 + e] = hh[e]; hs += hh[e] * hh[e]; }
        *(f32x4*)(p.out + (size_t)row * DM + c) = hh;
      }
#pragma unroll
    for (int i = 0; i < 2; ++i) *(u32x4*)(HB + (size_t)row * DM + i * 512 + lane * 8) = pack8(hv + i * 8);
    hs = wave_sum(hs);
    if (lane == 0) rstdh[row] = rsqrtf(hs * (1.f / DM) + 1e-6f);
  }
}
DI void phase_row_out(const Params& p) {
  unsigned char* ws = p.ws;
  const bf16_t* F = (const bf16_t*)(ws + OFF_F);
  const float* g = p.in[5];
  const int lane = threadIdx.x & 63, gw = blockIdx.x * NWV + (threadIdx.x >> 6), nw = gridDim.x * NWV;
  for (int row = gw; row < M_TOK; row += nw) {
    float m[16]; float ss = 0.f;
#pragma unroll
    for (int i = 0; i < 2; ++i) unpack8(*(const u32x4*)(F + (size_t)row * DM + i * 512 + lane * 8), m + i * 8);
#pragma unroll
    for (int e = 0; e < 16; ++e) ss += m[e] * m[e];
    ss = wave_sum(ss);
    const float rs = rsqrtf(ss * (1.f / DM) + 1e-6f);
#pragma unroll
    for (int i = 0; i < 2; ++i)
#pragma unroll
      for (int q = 0; q < 2; ++q) {
        const int c = i * 512 + lane * 8 + q * 4;
        float* op = p.out + (size_t)row * DM + c;
        const f32x4 hv = *(const f32x4*)op, gv = *(const f32x4*)(g + c);
        f32x4 r;
#pragma unroll
        for (int e = 0; e < 4; ++e) r[e] = hv[e] + m[i * 8 + q * 4 + e] * rs * gv[e];
        *(f32x4*)op = r;
      }
  }
}
DI void phase_convglu(const Params& p, int hf) {
  unsigned char* ws = p.ws;
  const bf16_t* HUP = (const bf16_t*)(ws + OFF_HUP); bf16_t* ACT = (bf16_t*)(ws + (hf ? OFF_ACT1 : OFF_ACT));
  const float* cw = p.in[24]; const float* cbias = p.in[25];
  constexpr int RB = 16, NCHK = DFF / 8;
  const int total = (HALF_ROWS / RB) * NCHK;
  for (int idx = blockIdx.x * NTHR + threadIdx.x; idx < total; idx += gridDim.x * NTHR) {
    const int rbk = idx / NCHK, c = (idx % NCHK) * 8, lr0 = rbk * RB, row0 = hf * HALF_ROWS + lr0;
    int start, T; seq_of(row0, start, T);
    const int pos0 = row0 - start;
    float w[2][3][8], bs[2][8];
#pragma unroll
    for (int part = 0; part < 2; ++part) {
#pragma unroll
      for (int d = 0; d < 3; ++d) {
        const f32x4 a = *(const f32x4*)(cw + d * 2 * DFF + part * DFF + c), b = *(const f32x4*)(cw + d * 2 * DFF + part * DFF + c + 4);
        w[part][d][0] = a.x; w[part][d][1] = a.y; w[part][d][2] = a.z; w[part][d][3] = a.w; w[part][d][4] = b.x; w[part][d][5] = b.y; w[part][d][6] = b.z; w[part][d][7] = b.w;
      }
      const f32x4 a = *(const f32x4*)(cbias + part * DFF + c), b = *(const f32x4*)(cbias + part * DFF + c + 4);
      bs[part][0] = a.x; bs[part][1] = a.y; bs[part][2] = a.z; bs[part][3] = a.w; bs[part][4] = b.x; bs[part][5] = b.y; bs[part][6] = b.z; bs[part][7] = b.w;
    }
    const bf16_t* hp = HUP + (size_t)lr0 * (2 * DFF) + c;
    float prev[2][8], cur[2][8], nxt[2][8];
#pragma unroll
    for (int part = 0; part < 2; ++part) {
      if (pos0 > 0) unpack8(*(const u32x4*)(hp - 2 * DFF + part * DFF), prev[part]); else { for (int e = 0; e < 8; ++e) prev[part][e] = 0.f; }
      unpack8(*(const u32x4*)(hp + part * DFF), cur[part]);
    }
#pragma unroll
    for (int r = 0; r < RB; ++r) {
      const bool hasn = pos0 + r < T - 1;
#pragma unroll
      for (int part = 0; part < 2; ++part) {
        if (hasn) unpack8(*(const u32x4*)(hp + (size_t)(r + 1) * (2 * DFF) + part * DFF), nxt[part]); else { for (int e = 0; e < 8; ++e) nxt[part][e] = 0.f; }
      }
      float o[8];
#pragma unroll
      for (int e = 0; e < 8; ++e) {
        const float x = prev[0][e] * w[0][0][e] + cur[0][e] * w[0][1][e] + nxt[0][e] * w[0][2][e] + bs[0][e];
        const float up = prev[1][e] * w[1][0][e] + cur[1][e] * w[1][1][e] + nxt[1][e] * w[1][2][e] + bs[1][e];
        const float u = 0.7978845608028654f * (x + 0.044715f * x * x * x);
        const float t2 = __expf(2.f * u); const float th = 1.f - 2.f / (t2 + 1.f);
        o[e] = 0.5f * x * (1.f + th) * up;
      }
      *(u32x4*)(ACT + (size_t)(lr0 + r) * DFF + c) = pack8(o);
#pragma unroll
      for (int part = 0; part < 2; ++part)
#pragma unroll
        for (int e = 0; e < 8; ++e) { prev[part][e] = cur[part][e]; cur[part][e] = nxt[part][e]; }
    }
  }
}

constexpr int NPHASE = 18;
constexpr int LDS_BYTES = 2 * STAGE8;
static_assert(LDS_BYTES >= 2 * 64 * 65 * 4 && LDS_BYTES >= 9216 + 64 * 68 * 2, "lds");

template <int PH>
DI void run_phase(const Params& p, unsigned char* lds) {
  unsigned char* ws = p.ws;
  if constexpr (PH == 0) phase_prep(p, lds);
  else if constexpr (PH == 1) { EpiScaleStore e{(bf16_t*)p.out, ZLD, (const float*)(ws + OFF_RSTDX), 0};
    gemm_phase((const bf16_t*)(ws + OFF_XB), DM, (const bf16_t*)(ws + OFF_WZT), DM, DM, 0, M_TOK, ZLD, lds, e); }
  else if constexpr (PH == 2) phase_rwprep(p);
  else if constexpr (PH == 3) {
#pragma unroll 1
    for (int d = 0; d < 2; ++d) {
      EpiW ew{(bf16_t*)((unsigned char*)p.out + (size_t)d * SEG), p.in[10] + d * 512};
      gemm_phase((const bf16_t*)(ws + OFF_LIN) + d * 64, LINW, (const bf16_t*)(ws + OFF_W2T) + d * 512 * 64, 64, 64, 0, M_TOK, RWW, lds, ew, d * 128);
      EpiA ea{(bf16_t*)((unsigned char*)p.out + (size_t)(2 + d) * SEG), (bf16_t*)(ws + OFF_BF + (size_t)d * SEG), (const bf16_t*)(ws + OFF_KSH),
              (const bf16_t*)(ws + OFF_NKK), p.in[12] + d * 512, p.in[16]};
      gemm_phase((const bf16_t*)(ws + OFF_LIN) + 128 + d * 64, LINW, (const bf16_t*)(ws + OFF_A2T) + d * 512 * 64, 64, 64, 0, M_TOK, RWW, lds, ea, 128 - d * 128);
    }
    EpiStore eg{(bf16_t*)(ws + OFF_G), RWW};
    gemm_phase((const bf16_t*)(ws + OFF_LIN) + 256, LINW, (const bf16_t*)(ws + OFF_G2T), 160, 160, 0, M_TOK, RWW, lds, eg);
  }
  else if constexpr (PH == 4) phase_scan(p, lds);
  else if constexpr (PH == 5) phase_scan_fix(p, lds);
  else if constexpr (PH == 6) phase_rwfinish(p);
  else if constexpr (PH == 7) { EpiQG e{(bf16_t*)(ws + OFF_QKV), (bf16_t*)(ws + OFF_SG), (const float*)(ws + OFF_RSTDX)};
    gemm_phase((const bf16_t*)(ws + OFF_XB), DM, (const bf16_t*)(ws + OFF_WQGT), DM, DM, 0, M_TOK, 2816, lds, e); }
  else if constexpr (PH == 8) { if (NAIVE_ATTN) phase_attn_naive(p); else phase_attn(p, lds); }
  else if constexpr (PH == 9) {
    EpiMerge1 e1{(bf16_t*)(ws + OFF_MERGED), (const bf16_t*)(ws + OFF_SG)};
    EpiMerge2 e2{(bf16_t*)(ws + OFF_MERGED), (const bf16_t*)(ws + OFF_SG)};
    const int ntn = DM / T8, ntm = M_TOK / T8;
    for (int t = blockIdx.x; t < ntn * ntm; t += gridDim.x) {
      int tm, tn; tile_of(t, ntm, ntn, tm, tn);
      gemm_tile8((const bf16_t*)(ws + OFF_OATT), 512, (const bf16_t*)(ws + OFF_WAT), 512, 512, tm * T8, tn * T8, lds, e1);
    }
    asm volatile("" ::: "memory");
    for (int t = blockIdx.x; t < ntn * ntm; t += gridDim.x) {
      int tm, tn; tile_of(t, ntm, ntn, tm, tn);
      gemm_tile8((const bf16_t*)(ws + OFF_ORW), 512, (const bf16_t*)(ws + OFF_WBT), 512, 512, tm * T8, tn * T8, lds, e2);
    }
  }
  else if constexpr (PH == 10) { EpiStore e{(bf16_t*)(ws + OFF_MO), DM};
    gemm_phase((const bf16_t*)(ws + OFF_MERGED), DM, (const bf16_t*)(ws + OFF_WOT), DM, DM, 0, M_TOK, DM, lds, e); }
  else if constexpr (PH == 11) phase_row_h(p);
  else if constexpr (PH == 12 || PH == 14) { constexpr int hf = PH == 12 ? 0 : 1;
    EpiScaleStore e{(bf16_t*)(ws + OFF_HUP), 2 * DFF, (const float*)(ws + OFF_RSTDH), hf * HALF_ROWS};
    gemm_phase((const bf16_t*)(ws + OFF_HB), DM, (const bf16_t*)(ws + OFF_WUPT), DM, DM, hf * HALF_ROWS, HALF_ROWS, 2 * DFF, lds, e); }
  else if constexpr (PH == 13 || PH == 15) phase_convglu(p, PH == 13 ? 0 : 1);
  else if constexpr (PH == 16) {
    EpiStore e{(bf16_t*)(ws + OFF_F), DM};
    const bf16_t* A0 = (const bf16_t*)(ws + OFF_ACT);
    const bf16_t* A1 = (const bf16_t*)(ws + OFF_ACT1) - (size_t)HALF_ROWS * DFF;
    const int ntn = DM / T8, ntm = M_TOK / T8;
    for (int t = blockIdx.x; t < ntn * ntm; t += gridDim.x) {
      int tm, tn; tile_of(t, ntm, ntn, tm, tn);
      gemm_tile8(tm * T8 < HALF_ROWS ? A0 : A1, DFF, (const bf16_t*)(ws + OFF_WDNT), DFF, DFF, tm * T8, tn * T8, lds, e);
    }
  }
  else if constexpr (PH == 17) phase_row_out(p);
}

constexpr size_t OFF_BAR = 1016 * MBY;
DI void grid_barrier(const Params& p, int k) {
  __syncthreads();
  if (threadIdx.x == 0) {
    unsigned* base = (unsigned*)(p.ws + OFF_BAR);
    const int g = blockIdx.x & 7, G = gridDim.x, ng = (G - g + 7) >> 3;
    const unsigned ngroups = G < 8 ? G : 8;
    __builtin_amdgcn_fence(__ATOMIC_RELEASE, "agent");
    const unsigned old = __hip_atomic_fetch_add(base + g * 64, 1u, __ATOMIC_RELAXED, __HIP_MEMORY_SCOPE_AGENT);
    if (old + 1 == (unsigned)(k * ng)) __hip_atomic_fetch_add(base + 8 * 64, 1u, __ATOMIC_RELAXED, __HIP_MEMORY_SCOPE_AGENT);
    while (__hip_atomic_load(base + 8 * 64, __ATOMIC_RELAXED, __HIP_MEMORY_SCOPE_AGENT) < (unsigned)k * ngroups) __builtin_amdgcn_s_sleep(1);
    __builtin_amdgcn_fence(__ATOMIC_ACQUIRE, "agent");
  }
  __syncthreads();
}

template <int PH>
DI void run_all(const Params& p, unsigned char* lds) {
  run_phase<PH>(p, lds);
  if constexpr (((DUP_MASK >> PH) & 1) != 0) { __syncthreads(); run_phase<PH>(p, lds); }
  if constexpr (PH + 1 < NPHASE) {
    if constexpr (PH == 0) cg::this_grid().sync();
    else grid_barrier(p, PH);
    run_all<PH + 1>(p, lds);
  }
}

__global__ void __launch_bounds__(512) mega_coop(Params p) {
  __shared__ __attribute__((aligned(16))) unsigned char lds[LDS_BYTES];
  if (blockIdx.x == 0 && threadIdx.x < 16) __hip_atomic_store((unsigned*)(p.ws + OFF_BAR) + threadIdx.x * 64, 0u, __ATOMIC_RELAXED, __HIP_MEMORY_SCOPE_AGENT);
  run_all<0>(p, lds);
}

template <int PH>
__global__ void __launch_bounds__(512) mega_one(Params p) {
  __shared__ __attribute__((aligned(16))) unsigned char lds[LDS_BYTES];
  run_phase<PH>(p, lds);
}

template <int PH>
static void launch_all(const Params& p, int grid, hipStream_t stream) {
  hipLaunchKernelGGL(mega_one<PH>, dim3(grid), dim3(NTHR), 0, stream, p);
  if constexpr (PH + 1 < NPHASE) launch_all<PH + 1>(p, grid, stream);
}

extern "C" void kernel_launch(void* const* d_in, const int* in_sizes, int n_in, void* d_out, int out_size, void* d_ws, size_t ws_size,
                              hipStream_t stream) {
  static int grid_blocks = 0;
  if (!grid_blocks) {
    int dev = 0, cus = 0, per_cu = 0;
    (void)hipGetDevice(&dev);
    (void)hipDeviceGetAttribute(&cus, hipDeviceAttributeMultiprocessorCount, dev);
    (void)hipOccupancyMaxActiveBlocksPerMultiprocessor(&per_cu, mega_coop, NTHR, 0);
    if (per_cu < 1) per_cu = 1;
    if (per_cu > 1) per_cu = 1;
    grid_blocks = cus * per_cu;
    if (ws_size < 1014 * MBY) fprintf(stderr, "kernel_launch: workspace too small (%zu)\n", ws_size);
  }
  Params p{};
  for (int i = 0; i < 27; ++i) p.in[i] = (const float*)d_in[i];
  p.out = (float*)d_out; p.ws = (unsigned char*)d_ws;
  if (COOP_MODE) {
    void* args[] = {&p};
    hipError_t e = hipLaunchCooperativeKernel((void*)mega_coop, dim3(grid_blocks), dim3(NTHR), args, 0, stream);
    if (e != hipSuccess) fprintf(stderr, "cooperative launch failed: %s (grid %d)\n", hipGetErrorString(e), grid_blocks);
  } else {
    launch_all<0>(p, grid_blocks, stream);
  }
}
```

```cpp
#include <hip/hip_runtime.h>
#include <hip/hip_cooperative_groups.h>
#include <cstdint>
#include <cstdio>
namespace cg = cooperative_groups;

#ifndef NAIVE_GEMM
#define NAIVE_GEMM 0
#endif
#ifndef NAIVE_TR
#define NAIVE_TR 0
#endif
#ifndef DUP_MASK
#define DUP_MASK 0
#endif
#ifndef COOP_MODE
#define COOP_MODE 1
#endif

typedef unsigned short bf16_t;
typedef short bf16x8 __attribute__((ext_vector_type(8)));
typedef short s16x4 __attribute__((ext_vector_type(4)));
typedef float f32x4 __attribute__((ext_vector_type(4)));
typedef float f32x2 __attribute__((ext_vector_type(2)));
typedef unsigned u32x4 __attribute__((ext_vector_type(4)));
typedef unsigned u32x2 __attribute__((ext_vector_type(2)));
typedef __bf16 bf16x2_t __attribute__((ext_vector_type(2)));
#define DI __device__ __forceinline__

constexpr int M_TOK = 81920, DM = 1024, T_P = 16384, T_S = 2048;
constexpr int IN_W = 4768, RWW = 512, DFF = 2816, ZW = 1952, ZLD = 2048, LINW = 416, QKVW = 768, SGW = 2048;
constexpr int HALF_ROWS = 40960;
constexpr int NTHR = 512, NWV = NTHR / 64;
constexpr size_t MBY = 1ull << 20;
constexpr size_t OFF_WZT = 0, OFF_WQGT = 4 * MBY, OFF_WAT = OFF_WQGT + 2816ull * 1024 * 2, OFF_WBT = OFF_WAT + MBY, OFF_WOT = OFF_WBT + MBY,
                 OFF_WUPT = OFF_WOT + 2 * MBY, OFF_WDNT = OFF_WUPT + 11 * MBY, OFF_W2T = 30 * MBY, OFF_A2T = OFF_W2T + 128 * 1024,
                 OFF_G2T = OFF_A2T + 128 * 1024;
constexpr size_t OFF_RSTDX = 32 * MBY, OFF_RSTDH = 33 * MBY;
constexpr size_t OFF_XB = 34 * MBY;
constexpr size_t OFF_R = 194 * MBY, OFF_V = 274 * MBY, OFF_NKK = 354 * MBY, OFF_BF = 434 * MBY  ;
constexpr size_t OFF_KSH = 594 * MBY, OFF_LIN = 674 * MBY, OFF_G = 739 * MBY, OFF_YS = 819 * MBY  ;
constexpr size_t OFF_QKV = 594 * MBY  , OFF_MERGED = 714 * MBY  , OFF_SG = 194 * MBY  ;
constexpr size_t OFF_MO = OFF_XB, OFF_HB = 194 * MBY, OFF_HUP = 354 * MBY  , OFF_ACT = 794 * MBY  , OFF_ACT1 = 34 * MBY  , OFF_F = 354 * MBY  ;
constexpr size_t SEG = (size_t)M_TOK * 512 * 2;

struct Params { const float* in[27]; float* out; unsigned char* ws; };

DI unsigned pk2(float lo, float hi) { f32x2 v = {lo, hi}; bf16x2_t b = __builtin_convertvector(v, bf16x2_t); return __builtin_bit_cast(unsigned, b); }
DI float lo2f(unsigned u) { return __uint_as_float(u << 16); }
DI float hi2f(unsigned u) { return __uint_as_float(u & 0xffff0000u); }
DI float bf2f(bf16_t v) { return __uint_as_float(((unsigned)v) << 16); }
DI void unpack8(const u32x4 u, float* f) { f[0] = lo2f(u.x); f[1] = hi2f(u.x); f[2] = lo2f(u.y); f[3] = hi2f(u.y); f[4] = lo2f(u.z); f[5] = hi2f(u.z); f[6] = lo2f(u.w); f[7] = hi2f(u.w); }
DI u32x4 pack8(const float* f) { u32x4 u; u.x = pk2(f[0], f[1]); u.y = pk2(f[2], f[3]); u.z = pk2(f[4], f[5]); u.w = pk2(f[6], f[7]); return u; }
DI float sigmoidf_(float x) { return 1.f / (1.f + __expf(-x)); }
DI float wave_sum(float v) {
#pragma unroll
  for (int o = 32; o >= 1; o >>= 1) v += __shfl_xor(v, o);
  return v;
}
DI void seq_of(int row, int& start, int& T) { if (row < T_P) { start = 0; T = T_P; } else { start = T_P + ((row - T_P) / T_S) * T_S; T = T_S; } }

DI void transpose_job(const float* __restrict__ src, int srcN, int K, int n0, int ncols, int ncols_pad, bf16_t* __restrict__ dst,
                              const float* __restrict__ scale, float* lds) {
  const int ntn = (ncols_pad + 63) / 64, ntk = (K + 63) / 64, tid = threadIdx.x;
  if (NAIVE_TR) {
    for (size_t idx = (size_t)blockIdx.x * NTHR + tid; idx < (size_t)ncols_pad * K; idx += (size_t)gridDim.x * NTHR) {
      const int n = (int)(idx / K), k = (int)(idx % K);
      float v = 0.f;
      if (n < ncols) { v = src[(size_t)k * srcN + n0 + n]; if (scale) v *= scale[k]; }
      dst[idx] = (bf16_t)(pk2(v, 0.f) & 0xffffu);
    }
    return;
  }
  for (int t = blockIdx.x; t < ntn * ntk; t += gridDim.x) {
    const int tk = t % ntk, tn = t / ntk;
#pragma unroll
    for (int i = 0; i < 64 / NWV; ++i) {
      const int kk = i * NWV + (tid >> 6), nn = tid & 63, k = tk * 64 + kk, n = tn * 64 + nn;
      float v = 0.f;
      if (k < K && n < ncols) { v = src[(size_t)k * srcN + n0 + n]; if (scale) v *= scale[k]; }
      lds[kk * 65 + nn] = v;
    }
    __syncthreads();
#pragma unroll
    for (int i = 0; i < 64 / NWV; ++i) {
      const int nn = i * NWV + (tid >> 6), kk = tid & 63, k = tk * 64 + kk, n = tn * 64 + nn;
      if (k < K && n < ncols_pad) { unsigned u = pk2(lds[kk * 65 + nn], 0.f); dst[(size_t)n * K + k] = (bf16_t)(u & 0xffffu); }
    }
    __syncthreads();
  }
}

DI void phase_prep(const Params& p, unsigned char* ldsb) {
  float* lds = (float*)ldsb;
  unsigned char* ws = p.ws;
  transpose_job(p.in[6], IN_W, 1024, 768, ZW, ZLD, (bf16_t*)(ws + OFF_WZT), p.in[2], lds);
  transpose_job(p.in[6], IN_W, 1024, 0, 768, 768, (bf16_t*)(ws + OFF_WQGT), p.in[2], lds);
  transpose_job(p.in[6], IN_W, 1024, 2720, 2048, 2048, (bf16_t*)(ws + OFF_WQGT) + 768 * 1024, p.in[2], lds);
  transpose_job(p.in[20], 1024, 512, 0, 1024, 1024, (bf16_t*)(ws + OFF_WAT), nullptr, lds);
  transpose_job(p.in[21], 1024, 512, 0, 1024, 1024, (bf16_t*)(ws + OFF_WBT), nullptr, lds);
  transpose_job(p.in[22], 1024, 1024, 0, 1024, 1024, (bf16_t*)(ws + OFF_WOT), nullptr, lds);
  transpose_job(p.in[23], 2 * DFF, 1024, 0, 2 * DFF, 2 * DFF, (bf16_t*)(ws + OFF_WUPT), p.in[4], lds);
  transpose_job(p.in[26], 1024, DFF, 0, 1024, 1024, (bf16_t*)(ws + OFF_WDNT), nullptr, lds);
  for (int d = 0; d < 2; ++d) {
    transpose_job(p.in[11] + d * 64 * 512, 512, 64, 0, 512, 512, (bf16_t*)(ws + OFF_W2T) + d * 512 * 64, nullptr, lds);
    transpose_job(p.in[13] + d * 64 * 512, 512, 64, 0, 512, 512, (bf16_t*)(ws + OFF_A2T) + d * 512 * 64, nullptr, lds);
  }
  transpose_job(p.in[14], 512, 160, 0, 512, 512, (bf16_t*)(ws + OFF_G2T), nullptr, lds);
  const int lane = threadIdx.x & 63, gw = blockIdx.x * NWV + (threadIdx.x >> 6), nw = gridDim.x * NWV;
  bf16_t* xb = (bf16_t*)(ws + OFF_XB);
  float* rstd = (float*)(ws + OFF_RSTDX);
  for (int row = gw; row < M_TOK; row += nw) {
    const float* src = row < T_P ? p.in[0] + (size_t)row * DM : p.in[1] + (size_t)(row - T_P) * DM;
    float ss = 0.f;
#pragma unroll
    for (int i = 0; i < 4; ++i) {
      const int c = (i * 64 + lane) * 4;
      const f32x4 v = *(const f32x4*)(src + c);
      ss += v.x * v.x + v.y * v.y + v.z * v.z + v.w * v.w;
      u32x2 o; o.x = pk2(v.x, v.y); o.y = pk2(v.z, v.w);
      *(u32x2*)(xb + (size_t)row * DM + c) = o;
    }
    ss = wave_sum(ss);
    if (lane == 0) rstd[row] = rsqrtf(ss * (1.f / DM) + 1e-6f);
  }
}

constexpr int LROW = 80;
template <int MT, int NT, class Epi>
DI void gemm_tile(const bf16_t* __restrict__ A, int lda, const bf16_t* __restrict__ Bt, int ldb, int K, int row0, int col0,
                  unsigned char* lds, Epi& epi) {
  constexpr int BM = 32 * MT, BN = 32 * NT, STAGE = (BM + BN) * LROW, ACH = BM * 4 / 256, BCH = BN * 4 / 256;
  const int tid = threadIdx.x, lane = tid & 63, wid = tid >> 6, wm = wid >> 1, wn = wid & 1, fr = lane & 15, fq = lane >> 4;
  f32x4 acc[MT][NT];
#pragma unroll
  for (int i = 0; i < MT; ++i)
#pragma unroll
    for (int j = 0; j < NT; ++j) acc[i][j] = (f32x4){0.f, 0.f, 0.f, 0.f};
  u32x4 ra[ACH], rb[BCH];
  const bf16_t* ap[ACH]; const bf16_t* bp[BCH];
#pragma unroll
  for (int i = 0; i < ACH; ++i) { const int c = tid + i * 256; ap[i] = A + (size_t)(row0 + (c >> 2)) * lda + (c & 3) * 8; }
#pragma unroll
  for (int i = 0; i < BCH; ++i) { const int c = tid + i * 256; bp[i] = Bt + (size_t)(col0 + (c >> 2)) * ldb + (c & 3) * 8; }
  const int nk = K / 32;
#pragma unroll
  for (int i = 0; i < ACH; ++i) ra[i] = *(const u32x4*)(ap[i]);
#pragma unroll
  for (int i = 0; i < BCH; ++i) rb[i] = *(const u32x4*)(bp[i]);
#pragma unroll
  for (int i = 0; i < ACH; ++i) { const int c = tid + i * 256; *(u32x4*)(lds + (c >> 2) * LROW + (c & 3) * 16) = ra[i]; }
#pragma unroll
  for (int i = 0; i < BCH; ++i) { const int c = tid + i * 256; *(u32x4*)(lds + BM * LROW + (c >> 2) * LROW + (c & 3) * 16) = rb[i]; }
  __syncthreads();
  for (int kt = 0; kt < nk; ++kt) {
    const bool more = kt + 1 < nk;
    if (more) {
#pragma unroll
      for (int i = 0; i < ACH; ++i) ra[i] = *(const u32x4*)(ap[i] + (kt + 1) * 32);
#pragma unroll
      for (int i = 0; i < BCH; ++i) rb[i] = *(const u32x4*)(bp[i] + (kt + 1) * 32);
    }
    const unsigned char* sa = lds + (kt & 1) * STAGE;
    const unsigned char* sb = sa + BM * LROW;
    bf16x8 af[MT], bfv[NT];
#pragma unroll
    for (int i = 0; i < MT; ++i) af[i] = *(const bf16x8*)(sa + (wm * MT * 16 + i * 16 + fr) * LROW + fq * 16);
#pragma unroll
    for (int j = 0; j < NT; ++j) bfv[j] = *(const bf16x8*)(sb + (wn * NT * 16 + j * 16 + fr) * LROW + fq * 16);
#pragma unroll
    for (int i = 0; i < MT; ++i)
#pragma unroll
      for (int j = 0; j < NT; ++j) acc[i][j] = __builtin_amdgcn_mfma_f32_16x16x32_bf16(bfv[j], af[i], acc[i][j], 0, 0, 0);
    if (more) {
      unsigned char* da = lds + ((kt + 1) & 1) * STAGE;
#pragma unroll
      for (int i = 0; i < ACH; ++i) { const int c = tid + i * 256; *(u32x4*)(da + (c >> 2) * LROW + (c & 3) * 16) = ra[i]; }
#pragma unroll
      for (int i = 0; i < BCH; ++i) { const int c = tid + i * 256; *(u32x4*)(da + BM * LROW + (c >> 2) * LROW + (c & 3) * 16) = rb[i]; }
    }
    __syncthreads();
  }
#pragma unroll
  for (int i = 0; i < MT; ++i)
#pragma unroll
    for (int j = 0; j < NT; ++j) epi(row0 + wm * MT * 16 + i * 16 + fr, col0 + wn * NT * 16 + j * 16 + fq * 4, acc[i][j]);
}


#ifndef NAIVE_GEMM
#define NAIVE_GEMM 0
#endif
#ifndef NAIVE_TR
#define NAIVE_TR 0
#endif
template <int MT, int NT, class Epi>
DI void gemm_tile_naive(const bf16_t* A, int lda, const bf16_t* Bt, int ldb, int K, int row0, int col0, Epi& epi) {
  const int tid = threadIdx.x, lane = tid & 63, wid = tid >> 6, wm = wid >> 1, wn = wid & 1, fr = lane & 15, fq = lane >> 4;
  for (int i = 0; i < MT; ++i)
    for (int j = 0; j < NT; ++j) {
      const int row = row0 + wm * MT * 16 + i * 16 + fr, col = col0 + wn * NT * 16 + j * 16 + fq * 4;
      f32x4 acc = {0.f, 0.f, 0.f, 0.f};
      for (int k = 0; k < K; k += 8) {
        float a[8]; unpack8(*(const u32x4*)(A + (size_t)row * lda + k), a);
#pragma unroll
        for (int jj = 0; jj < 4; ++jj) { float b[8]; unpack8(*(const u32x4*)(Bt + (size_t)(col + jj) * ldb + k), b);
#pragma unroll
          for (int e = 0; e < 8; ++e) acc[jj] += a[e] * b[e]; }
      }
      epi(row, col, acc);
    }
}
DI void store4(bf16_t* ptr, f32x4 v) { u32x2 o; o.x = pk2(v.x, v.y); o.y = pk2(v.z, v.w); *(u32x2*)ptr = o; }
DI f32x4 load4(const bf16_t* ptr) { const u32x2 u = *(const u32x2*)ptr; return (f32x4){lo2f(u.x), hi2f(u.x), lo2f(u.y), hi2f(u.y)}; }

constexpr int GMT = 8, GNT = 4, GBM = 32 * GMT, GBN = 32 * GNT;

struct EpiScaleStore { bf16_t* O; int ldo; const float* rstd; int rowoff;
  DI void operator()(int row, int col, f32x4 v) { const float s = rstd[row]; store4(O + (size_t)(row - rowoff) * ldo + col, v * s); } };
struct EpiQG { bf16_t* qkv; bf16_t* sg; const float* rstd;
  DI void operator()(int row, int col, f32x4 v) { const float s = rstd[row]; v = v * s;
    if (col < QKVW) store4(qkv + (size_t)row * QKVW + col, v);
    else { f32x4 g = {sigmoidf_(v.x), sigmoidf_(v.y), sigmoidf_(v.z), sigmoidf_(v.w)}; store4(sg + (size_t)row * SGW + (col - QKVW), g); } } };
struct EpiGate { bf16_t* sg; const float* rstd;
  DI void operator()(int row, int col, f32x4 v) { const float s = rstd[row]; v = v * s;
    f32x4 g = {sigmoidf_(v.x), sigmoidf_(v.y), sigmoidf_(v.z), sigmoidf_(v.w)}; store4(sg + (size_t)row * SGW + col, g); } };
struct EpiW { bf16_t* O; const float* w0;
  DI void operator()(int row, int col, f32x4 v) { f32x4 o;
#pragma unroll
    for (int j = 0; j < 4; ++j) { const float x = w0[col + j] + v[j]; const float sp = fmaxf(-x, 0.f) + __logf(1.f + __expf(-fabsf(x)));
      const float e = __expf(-sp - 0.5f); o[j] = 1.f - __expf(-e); }
    store4(O + (size_t)row * RWW + col, o); } };
struct EpiA { bf16_t* KO; bf16_t* BO; const bf16_t* ksh; const bf16_t* nkk; const float* a0; const float* k_a;
  DI void operator()(int row, int col, f32x4 v) { const f32x4 k = load4(ksh + (size_t)row * RWW + col), nk = load4(nkk + (size_t)row * RWW + col); f32x4 ko, bo;
#pragma unroll
    for (int j = 0; j < 4; ++j) { const float a = sigmoidf_(a0[col + j] + v[j]); ko[j] = k[j] * (1.f + (a - 1.f) * k_a[col + j]); bo[j] = -nk[j] * a; }
    store4(KO + (size_t)row * RWW + col, ko); store4(BO + (size_t)row * RWW + col, bo); } };
struct EpiStore { bf16_t* O; int ldo;
  DI void operator()(int row, int col, f32x4 v) { store4(O + (size_t)row * ldo + col, v); } };
struct EpiMerge1 { bf16_t* O; const bf16_t* sg;
  DI void operator()(int row, int col, f32x4 v) { const f32x4 g = load4(sg + (size_t)row * SGW + col); store4(O + (size_t)row * DM + col, v * g); } };
struct EpiMerge2 { bf16_t* O; const bf16_t* sg;
  DI void operator()(int row, int col, f32x4 v) { const f32x4 g = load4(sg + (size_t)row * SGW + 1024 + col); bf16_t* o = O + (size_t)row * DM + col; const f32x4 prev = load4(o); store4(o, prev + v * g); } };

constexpr int LROW8 = 144, T8 = 256, STAGE8 = 2 * T8 * LROW8;
template <class Epi>
DI void gemm_tile8(const bf16_t* __restrict__ A, int lda, const bf16_t* __restrict__ Bt, int ldb, int K, int row0, int col0,
                   unsigned char* lds, Epi& epi) {
  const int tid = threadIdx.x, lane = tid & 63, wid = tid >> 6, wm = wid >> 2, wn = wid & 3, fr = lane & 15, fq = lane >> 4;
  f32x4 acc[8][4];
#pragma unroll
  for (int i = 0; i < 8; ++i)
#pragma unroll
    for (int j = 0; j < 4; ++j) acc[i][j] = (f32x4){0.f, 0.f, 0.f, 0.f};
  u32x4 ra[4], rb[4];
  const int lrow = tid >> 3, lkc = tid & 7;
  const bf16_t* ap = A + (size_t)(row0 + lrow) * lda + lkc * 8;
  const bf16_t* bp = Bt + (size_t)(col0 + lrow) * ldb + lkc * 8;
  const size_t astep = (size_t)64 * lda, bstep = (size_t)64 * ldb;
  unsigned char* wa = lds + lrow * LROW8 + lkc * 16;
  const int nk = K / 64, krem = K & 63;
#pragma unroll
  for (int i = 0; i < 4; ++i) ra[i] = *(const u32x4*)(ap + i * astep);
#pragma unroll
  for (int i = 0; i < 4; ++i) rb[i] = *(const u32x4*)(bp + i * bstep);
#pragma unroll
  for (int i = 0; i < 4; ++i) *(u32x4*)(wa + i * 64 * LROW8) = ra[i];
#pragma unroll
  for (int i = 0; i < 4; ++i) *(u32x4*)(wa + T8 * LROW8 + i * 64 * LROW8) = rb[i];
  __syncthreads();
  const int nkt = nk + (krem ? 1 : 0);
  for (int kt = 0; kt < nkt; ++kt) {
    const bool more = kt + 1 < nkt;
    const unsigned char* sa = lds + (kt & 1) * STAGE8 + (wm * 128 + fr) * LROW8 + fq * 16;
    const unsigned char* sb = lds + (kt & 1) * STAGE8 + T8 * LROW8 + (wn * 64 + fr) * LROW8 + fq * 16;
    const int nsub = (kt == nk) ? 1 : 2;
#pragma unroll
    for (int ks = 0; ks < 2; ++ks) {
      if (ks < nsub) {
        bf16x8 bfv[4];
#pragma unroll
        for (int j = 0; j < 4; ++j) bfv[j] = *(const bf16x8*)(sb + j * 16 * LROW8 + ks * 64);
#pragma unroll
        for (int ih = 0; ih < 2; ++ih) {
          bf16x8 af[4];
#pragma unroll
          for (int i = 0; i < 4; ++i) af[i] = *(const bf16x8*)(sa + (ih * 4 + i) * 16 * LROW8 + ks * 64);
#pragma unroll
          for (int i = 0; i < 4; ++i)
#pragma unroll
            for (int j = 0; j < 4; ++j) acc[ih * 4 + i][j] = __builtin_amdgcn_mfma_f32_16x16x32_bf16(bfv[j], af[i], acc[ih * 4 + i][j], 0, 0, 0);
          if (ks == 0) {
            asm volatile("" ::: "memory");
            if (more) {
              const int koff = (kt + 1) * 64 - ((kt + 1 == nk && krem && lkc >= 4) ? 32 : 0);
              if (ih == 0) {
#pragma unroll
                for (int i = 0; i < 4; ++i) ra[i] = *(const u32x4*)(ap + i * astep + koff);
              } else {
#pragma unroll
                for (int i = 0; i < 4; ++i) rb[i] = *(const u32x4*)(bp + i * bstep + koff);
              }
            }
            asm volatile("" ::: "memory");
          }
        }
      }
    }
    if (more) {
      unsigned char* da = wa + ((kt + 1) & 1) * STAGE8;
#pragma unroll
      for (int i = 0; i < 4; ++i) *(u32x4*)(da + i * 64 * LROW8) = ra[i];
#pragma unroll
      for (int i = 0; i < 4; ++i) *(u32x4*)(da + T8 * LROW8 + i * 64 * LROW8) = rb[i];
    }
    __syncthreads();
  }
#pragma unroll
  for (int i = 0; i < 8; ++i)
#pragma unroll
    for (int j = 0; j < 4; ++j) epi(row0 + wm * 128 + i * 16 + fr, col0 + wn * 64 + j * 16 + fq * 4, acc[i][j]);
}

DI void tile_of(int t, int ntm, int ntn, int& tm, int& tn) {
  const int G = gridDim.x;
  if ((G & 7) == 0 && (ntm & 31) == 0) {
    const int x = t & 7, l = (t >> 3), mper = ntm >> 3;
    const int gs = (mper & 7) == 0 ? 8 : 4;
    const int grp = l / (gs * ntn), r = l % (gs * ntn);
    tm = x * mper + grp * gs + (r % gs); tn = r / gs;
  } else { tm = t / ntn; tn = t % ntn; }
}
template <int MT = 0, class Epi>
DI void gemm_phase(const bf16_t* A, int lda, const bf16_t* Bt, int ldb, int K, int rows0, int nrows, int N, unsigned char* lds, Epi& epi, int rot = 0) {
  const int ntn = N / T8, ntm = nrows / T8;
  for (int t = (int)((blockIdx.x + rot) % gridDim.x); t < ntn * ntm; t += gridDim.x) {
    int tm, tn; tile_of(t, ntm, ntn, tm, tn);
    gemm_tile8(A, lda, Bt, ldb, K, rows0 + tm * T8, tn * T8, lds, epi);
  }
}

DI void phase_rwprep(const Params& p) {
  unsigned char* ws = p.ws;
  const bf16_t* z = (const bf16_t*)p.out;
  bf16_t* R = (bf16_t*)(ws + OFF_R); bf16_t* V = (bf16_t*)(ws + OFF_V); bf16_t* NKK = (bf16_t*)(ws + OFF_NKK);
  bf16_t* KSH = (bf16_t*)(ws + OFF_KSH); bf16_t* LIN = (bf16_t*)(ws + OFF_LIN);
  const float* mup = p.in[8]; const float* mun = p.in[9]; const float* k_k = p.in[15];
  const int lane = threadIdx.x & 63, gw = blockIdx.x * NWV + (threadIdx.x >> 6), nw = gridDim.x * NWV;
  constexpr int RB = 8;
  for (int rbk = gw; rbk < M_TOK / RB; rbk += nw) {
    const int row0 = rbk * RB;
    int start, T; seq_of(row0, start, T);
    const int pos0 = row0 - start;
#pragma unroll
    for (int seg = 0; seg < 4; ++seg) {
      const int c = seg < 3 ? seg * 512 + lane * 8 : 1536 + lane * 8;
      if (seg == 3 && lane >= 52) break;
      float mp[8], mn[8], kkw[8];
#pragma unroll
      for (int e = 0; e < 8; ++e) { mp[e] = mup[c + e]; mn[e] = mun[c + e]; kkw[e] = seg == 1 ? k_k[lane * 8 + e] : 0.f; }
      const bf16_t* zr = z + (size_t)row0 * ZLD + c;
      float zp[8], zc[8], zn[8], zs[8];
      if (pos0 > 0) unpack8(*(const u32x4*)(zr - ZLD), zp); else { for (int e = 0; e < 8; ++e) zp[e] = 0.f; }
      unpack8(*(const u32x4*)zr, zc);
#pragma unroll
      for (int r = 0; r < RB; ++r) {
        const int row = row0 + r;
        if (pos0 + r < T - 1) unpack8(*(const u32x4*)(zr + (size_t)(r + 1) * ZLD), zn); else { for (int e = 0; e < 8; ++e) zn[e] = 0.f; }
#pragma unroll
        for (int e = 0; e < 8; ++e) zs[e] = zc[e] + mp[e] * (zp[e] - zc[e]) + mn[e] * (zn[e] - zc[e]);
        if (seg == 0) *(u32x4*)(R + (size_t)row * RWW + lane * 8) = pack8(zs);
        else if (seg == 2) *(u32x4*)(V + (size_t)row * RWW + lane * 8) = pack8(zs);
        else if (seg == 1) {
          *(u32x4*)(KSH + (size_t)row * RWW + lane * 8) = pack8(zs);
          float kk[8], ss = 0.f;
#pragma unroll
          for (int e = 0; e < 8; ++e) { kk[e] = zs[e] * kkw[e]; ss += kk[e] * kk[e]; }
          ss += __shfl_xor(ss, 1); ss += __shfl_xor(ss, 2); ss += __shfl_xor(ss, 4);
          const float inv = -1.f / fmaxf(sqrtf(ss), 1e-12f);
#pragma unroll
          for (int e = 0; e < 8; ++e) kk[e] *= inv;
          *(u32x4*)(NKK + (size_t)row * RWW + lane * 8) = pack8(kk);
        } else {
#pragma unroll
          for (int e = 0; e < 8; ++e) {
            if (lane < 16) { const float t2 = __expf(2.f * zs[e]); zs[e] = 1.f - 2.f / (t2 + 1.f); }
            else if (lane >= 32) zs[e] = sigmoidf_(zs[e]);
          }
          *(u32x4*)(LIN + (size_t)row * LINW + lane * 8) = pack8(zs);
        }
#pragma unroll
        for (int e = 0; e < 8; ++e) { zp[e] = zc[e]; zc[e] = zn[e]; }
      }
    }
  }
}

DI float dpp_xor1(float v) { return __builtin_bit_cast(float, __builtin_amdgcn_update_dpp(0, __builtin_bit_cast(int, v), 0xB1, 0xF, 0xF, false)); }
DI float dpp_xor2(float v) { return __builtin_bit_cast(float, __builtin_amdgcn_update_dpp(0, __builtin_bit_cast(int, v), 0x4E, 0xF, 0xF, false)); }
struct ScanRaw { u32x4 r[2], w[2], k[2], a[2], b[2]; u32x2 v; };
DI void unpack16_2(const u32x4* u, f32x2* f) {
#pragma unroll
  for (int i = 0; i < 2; ++i) { f[i * 4 + 0] = (f32x2){lo2f(u[i].x), hi2f(u[i].x)}; f[i * 4 + 1] = (f32x2){lo2f(u[i].y), hi2f(u[i].y)};
    f[i * 4 + 2] = (f32x2){lo2f(u[i].z), hi2f(u[i].z)}; f[i * 4 + 3] = (f32x2){lo2f(u[i].w), hi2f(u[i].w)}; }
}
constexpr int NCH = 8, CHL = T_P / NCH;
constexpr size_t OFF_QB = 979 * MBY  , OFF_ST = 1011 * MBY  ;
constexpr int SCAN_TS = 8, SCAN_WLDS = SCAN_TS * 6 * 64 * 4;
DI void phase_scan(const Params& p, unsigned char* ldsb) {
  unsigned char* ws = p.ws;
  const bf16_t* R = (const bf16_t*)(ws + OFF_R); const bf16_t* V = (const bf16_t*)(ws + OFF_V); const bf16_t* NKK = (const bf16_t*)(ws + OFF_NKK);
  const int wid = threadIdx.x >> 6, lane = threadIdx.x & 63, rg = lane >> 2, cgp = lane & 3;
  float* L = (float*)(ldsb + wid * SCAN_WLDS);
  const int sst = lane >> 3, sch = lane & 7;
  constexpr int NCHAIN = 32 * 16 + NCH * 16 * 2;
  for (int chain = blockIdx.x * 3 + wid; wid < 3 && chain < NCHAIN; chain += 3 * gridDim.x) {
    int hd, start, T, i0, mode, cidx = 0;
    if (chain < 512) { hd = chain & 15; start = T_P + (chain >> 4) * T_S; T = T_S; i0 = 0; mode = 0; }
    else { const int pc = chain - 512; mode = pc & 1; hd = (pc >> 1) & 15; cidx = pc >> 5; start = 0; T = T_P; i0 = cidx * CHL; }
    const int h = hd >> 1, d = hd & 1;
    const bf16_t* Wd = (const bf16_t*)((const unsigned char*)p.out + (size_t)d * SEG);
    const bf16_t* Kd = (const bf16_t*)((const unsigned char*)p.out + (size_t)(2 + d) * SEG);
    const bf16_t* Bd = (const bf16_t*)(ws + OFF_BF + (size_t)d * SEG);
    bf16_t* YS = mode ? (bf16_t*)(ws + OFF_QB + (size_t)d * T_P * RWW * 2) : (bf16_t*)(ws + OFF_YS + (size_t)d * SEG);
    const int rb = h * 64 + rg * 4;
    f32x2 S[4][8];
#pragma unroll
    for (int r = 0; r < 4; ++r)
#pragma unroll
      for (int c = 0; c < 8; ++c) {
        const int row = rg * 4 + r, col = cgp * 16 + 2 * c;
        S[r][c] = (f32x2){(mode && row == col) ? 1.f : 0.f, (mode && row == col + 1) ? 1.f : 0.f};
      }
    u32x4 g[6];
    auto gload = [&](int ic) {
      const int i = ic + sst, t = d ? T - 1 - i : i; const size_t o = (size_t)(start + t) * RWW + h * 64 + sch * 8;
      g[0] = *(const u32x4*)(NKK + o); g[1] = *(const u32x4*)(Wd + o); g[2] = *(const u32x4*)(Bd + o);
      g[3] = *(const u32x4*)(Kd + o); g[4] = *(const u32x4*)(R + o); g[5] = *(const u32x4*)(V + o);
    };
    auto lwrite = [&]() {
#pragma unroll
      for (int x = 0; x < 6; ++x) {
        float f[8]; unpack8(g[x], f);
        if (x == 1) { for (int e = 0; e < 8; ++e) f[e] = 1.f - f[e]; }
        if (x == 5 && mode) { for (int e = 0; e < 8; ++e) f[e] = 0.f; }
        float* dst = L + sst * 384 + x * 64 + sch * 8;
        *(f32x4*)dst = (f32x4){f[0], f[1], f[2], f[3]}; *(f32x4*)(dst + 4) = (f32x4){f[4], f[5], f[6], f[7]};
      }
    };
    gload(i0); lwrite();
    const int iend = i0 + T_S;
#pragma unroll 1
    for (int ic = i0; ic < iend; ic += SCAN_TS) {
      const bool more = ic + SCAN_TS < iend;
      if (more) gload(ic + SCAN_TS);
#pragma unroll
      for (int s = 0; s < SCAN_TS; ++s) {
        const float* Ls = L + s * 384;
        const f32x4 vq = *(const f32x4*)(Ls + 5 * 64 + rg * 4);
        const float vv[4] = {vq.x, vq.y, vq.z, vq.w};
        f32x2 sa2[4], y2[4];
        {
          f32x2 aa[8];
#pragma unroll
          for (int q = 0; q < 4; ++q) { const f32x4 t4 = *(const f32x4*)(Ls + 0 * 64 + cgp * 16 + q * 4); aa[2 * q] = (f32x2){t4.x, t4.y}; aa[2 * q + 1] = (f32x2){t4.z, t4.w}; }
#pragma unroll
          for (int r = 0; r < 4; ++r) {
            f32x2 s2 = S[r][0] * aa[0];
#pragma unroll
            for (int c = 1; c < 8; ++c) s2 += S[r][c] * aa[c];
            float sa = s2.x + s2.y;
            sa += dpp_xor1(sa); sa += dpp_xor2(sa);
            sa2[r] = (f32x2){sa, sa}; y2[r] = (f32x2){0.f, 0.f};
          }
        }
#pragma unroll
        for (int q = 0; q < 4; ++q) {
          const f32x4 w4 = *(const f32x4*)(Ls + 1 * 64 + cgp * 16 + q * 4), b4 = *(const f32x4*)(Ls + 2 * 64 + cgp * 16 + q * 4);
          const f32x4 k4 = *(const f32x4*)(Ls + 3 * 64 + cgp * 16 + q * 4), r4 = *(const f32x4*)(Ls + 4 * 64 + cgp * 16 + q * 4);
#pragma unroll
          for (int hh = 0; hh < 2; ++hh) {
            const int c = 2 * q + hh;
            const f32x2 w = hh ? (f32x2){w4.z, w4.w} : (f32x2){w4.x, w4.y}, b = hh ? (f32x2){b4.z, b4.w} : (f32x2){b4.x, b4.y};
            const f32x2 k = hh ? (f32x2){k4.z, k4.w} : (f32x2){k4.x, k4.y}, rr = hh ? (f32x2){r4.z, r4.w} : (f32x2){r4.x, r4.y};
#pragma unroll
            for (int r = 0; r < 4; ++r) {
              const f32x2 v2 = {vv[r], vv[r]};
              S[r][c] = S[r][c] * w + (sa2[r] * b + v2 * k);
              y2[r] += S[r][c] * rr;
            }
          }
        }
        float y[4];
#pragma unroll
        for (int r = 0; r < 4; ++r) { float yy = y2[r].x + y2[r].y; yy += dpp_xor1(yy); yy += dpp_xor2(yy); y[r] = yy; }
        if (cgp == 0) {
          const int i = ic + s, t = d ? T - 1 - i : i;
          u32x2 o; o.x = pk2(y[0], y[1]); o.y = pk2(y[2], y[3]);
          *(u32x2*)(YS + (size_t)(start + t) * RWW + rb) = o;
        }
      }
      if (more) lwrite();
    }
    if (chain >= 512) {
      float* st = (float*)(ws + OFF_ST) + ((size_t)(cidx * 16 + hd) * 2 + mode) * 4096;
#pragma unroll
      for (int r = 0; r < 4; ++r)
#pragma unroll
        for (int c = 0; c < 8; ++c) *(f32x2*)(st + (rg * 4 + r) * 64 + cgp * 16 + 2 * c) = S[r][c];
    }
  }
}

DI void phase_scan_fix(const Params& p, unsigned char* ldsb) {
  unsigned char* ws = p.ws;
  const int tid = threadIdx.x, lane = tid & 63, wid = tid >> 6;
  constexpr int NSUB = 2, SUBL = CHL / NSUB;
  float* SA = (float*)ldsb; float* SB = SA + 64 * 65;
  for (int item = blockIdx.x; item < (NCH - 1) * 16 * NSUB; item += gridDim.x) {
    const int c = 1 + item / (16 * NSUB), rem = item % (16 * NSUB), hd = rem / NSUB, sub = rem % NSUB, h = hd >> 1, d = hd & 1;
    const int fi = (tid & 255) >> 2, fj = (tid & 3) * 16;
    float* cur = SA; float* nxt = SB;
    __syncthreads();
    {
      const float* U0 = (const float*)(ws + OFF_ST) + ((size_t)(0 * 16 + hd) * 2 + 0) * 4096;
      if (tid < 256) {
#pragma unroll
        for (int k = 0; k < 16; ++k) cur[fi * 65 + fj + k] = U0[fi * 64 + fj + k];
      }
    }
    __syncthreads();
#pragma unroll 1
    for (int cc = 1; cc < c; ++cc) {
      const float* U = (const float*)(ws + OFF_ST) + ((size_t)(cc * 16 + hd) * 2 + 0) * 4096;
      const float* P = U + 4096;
      if (tid < 256) {
      f32x4 acc[4];
#pragma unroll
      for (int j = 0; j < 4; ++j) acc[j] = *(const f32x4*)(U + fi * 64 + fj + j * 4);
#pragma unroll 4
      for (int m = 0; m < 64; ++m) {
        const float s = cur[fi * 65 + m];
#pragma unroll
        for (int j = 0; j < 4; ++j) acc[j] += *(const f32x4*)(P + m * 64 + fj + j * 4) * s;
      }
#pragma unroll
      for (int j = 0; j < 4; ++j) { nxt[fi * 65 + fj + j * 4] = acc[j].x; nxt[fi * 65 + fj + j * 4 + 1] = acc[j].y; nxt[fi * 65 + fj + j * 4 + 2] = acc[j].z; nxt[fi * 65 + fj + j * 4 + 3] = acc[j].w; }
      }
      __syncthreads();
      float* t2 = cur; cur = nxt; nxt = t2;
    }
    float S[64];
#pragma unroll
    for (int j = 0; j < 64; ++j) S[j] = cur[lane * 65 + j];
    const bf16_t* QB = (const bf16_t*)(ws + OFF_QB + (size_t)d * T_P * RWW * 2);
    bf16_t* YS = (bf16_t*)(ws + OFF_YS + (size_t)d * SEG);
#pragma unroll 1
    for (int i = c * CHL + sub * SUBL + wid; i < c * CHL + (sub + 1) * SUBL; i += NWV) {
      const int t = d ? T_P - 1 - i : i; const size_t o = (size_t)t * RWW + h * 64;
      float corr = 0.f;
#pragma unroll
      for (int c8 = 0; c8 < 8; ++c8) { float q[8]; unpack8(*(const u32x4*)(QB + o + c8 * 8), q);
#pragma unroll
        for (int e = 0; e < 8; ++e) corr += S[c8 * 8 + e] * q[e]; }
      const float y = bf2f(YS[o + lane]) + corr;
      YS[o + lane] = (bf16_t)(pk2(y, 0.f) & 0xffffu);
    }
  }
}

DI void phase_rwfinish(const Params& p) {
  unsigned char* ws = p.ws;
  const bf16_t* YF = (const bf16_t*)(ws + OFF_YS); const bf16_t* YB = (const bf16_t*)(ws + OFF_YS + SEG);
  const bf16_t* R = (const bf16_t*)(ws + OFF_R); const bf16_t* V = (const bf16_t*)(ws + OFF_V); const bf16_t* G = (const bf16_t*)(ws + OFF_G);
  const bf16_t* KF = (const bf16_t*)((const unsigned char*)p.out + 2 * SEG); const bf16_t* KB = (const bf16_t*)((const unsigned char*)p.out + 3 * SEG);
  bf16_t* O = (bf16_t*)p.out;
  const float* r_k = p.in[17]; const float* ln_w = p.in[18]; const float* ln_b = p.in[19];
  const int lane = threadIdx.x & 63, gw = blockIdx.x * NWV + (threadIdx.x >> 6), nw = gridDim.x * NWV;
  for (int it = gw; it < M_TOK * 2; it += nw) {
    const int row = it >> 1, ch = (it & 1) * 256 + lane * 4;
    const size_t o = (size_t)row * RWW + ch;
    const f32x4 yf = load4(YF + o), yb = load4(YB + o), r = load4(R + o), kf = load4(KF + o), kb = load4(KB + o), v = load4(V + o), g = load4(G + o);
    const f32x4 y = yf + yb;
    const f32x4 rk = *(const f32x4*)(r_k + ch);
    float s = y.x + y.y + y.z + y.w;
    const f32x4 bq = r * (kf + kb) * rk;
    float bs = bq.x + bq.y + bq.z + bq.w;
#pragma unroll
    for (int m = 1; m < 16; m <<= 1) { s += __shfl_xor(s, m); bs += __shfl_xor(bs, m); }
    const float mu = s * (1.f / 64.f);
    const f32x4 dv = y - mu;
    float q = dv.x * dv.x + dv.y * dv.y + dv.z * dv.z + dv.w * dv.w;
#pragma unroll
    for (int m = 1; m < 16; m <<= 1) q += __shfl_xor(q, m);
    const float rs = rsqrtf(q * (1.f / 64.f) + 64e-5f);
    const f32x4 lw = *(const f32x4*)(ln_w + ch), lb = *(const f32x4*)(ln_b + ch);
    const f32x4 res = (dv * rs * lw + lb + v * bs) * g;
    store4(O + o, res);
  }
}

DI void phase_attn(const Params& p, unsigned char* lds) {
  unsigned char* ws = p.ws;
  const bf16_t* qkv = (const bf16_t*)(ws + OFF_QKV);
  bf16_t* oatt = (bf16_t*)(ws + OFF_QKV);
  const int tid = threadIdx.x, lane = tid & 63, wid = tid >> 6, fr = lane & 15, fq = lane >> 4;
  const int kvh = wid >> 2;
  bf16_t* KsAll = (bf16_t*)lds; bf16_t* VtAll = (bf16_t*)(lds + 9216);
  const bf16_t* Ks = KsAll + kvh * (32 * 72);
  const bf16_t* Vt = VtAll + kvh * (64 * 36);
  const int njobs = M_TOK / 32;
  for (int job = blockIdx.x; job < njobs; job += gridDim.x) {
    const int q0 = job * 32;
    int start, T; seq_of(q0, start, T);
    const int h = wid;
    const float slope = exp2f(-(float)(h + 1)), sink = p.in[7][h];
    bf16x8 qf[2][2];
#pragma unroll
    for (int mt = 0; mt < 2; ++mt)
#pragma unroll
      for (int ks = 0; ks < 2; ++ks) qf[mt][ks] = *(const bf16x8*)(qkv + (size_t)(q0 + mt * 16 + fr) * QKVW + h * 64 + ks * 32 + fq * 8);
    f32x4 o[4][2];
#pragma unroll
    for (int a = 0; a < 4; ++a)
#pragma unroll
      for (int b = 0; b < 2; ++b) o[a][b] = (f32x4){0.f, 0.f, 0.f, 0.f};
    float mrun[2], lrun[2];
#pragma unroll
    for (int mt = 0; mt < 2; ++mt) { mrun[mt] = sink; lrun[mt] = fq == 0 ? 1.f : 0.f; }
#pragma unroll 1
    for (int kt = 0; kt < 9; ++kt) {
      const int kb = q0 - 128 + kt * 32, kbr = kb - start;
      if (kbr < 128 || kbr >= T + 128) continue;
      const bool phantom = kbr >= T;
      __syncthreads();
      {
        const int skv = tid >> 8, key = (tid & 255) >> 3, dc = tid & 7;
        const bf16_t* src = qkv + (size_t)(kb + key) * QKVW + 512 + skv * 64 + dc * 8;
        u32x4 kvv = {0u, 0u, 0u, 0u}, vv = {0u, 0u, 0u, 0u};
        if (!phantom) { kvv = *(const u32x4*)src; vv = *(const u32x4*)(src + 128); }
        bf16_t* Vw = VtAll + skv * (64 * 36);
        *(u32x4*)(KsAll + skv * (32 * 72) + key * 72 + dc * 8) = kvv;
        const unsigned w[4] = {vv.x, vv.y, vv.z, vv.w};
#pragma unroll
        for (int e = 0; e < 4; ++e) { Vw[(dc * 8 + 2 * e) * 36 + key] = (bf16_t)(w[e] & 0xffffu); Vw[(dc * 8 + 2 * e + 1) * 36 + key] = (bf16_t)(w[e] >> 16); }
      }
      __syncthreads();
#pragma unroll
      for (int mt = 0; mt < 2; ++mt) {
        f32x4 s[2];
#pragma unroll
        for (int nt = 0; nt < 2; ++nt) {
          s[nt] = (f32x4){0.f, 0.f, 0.f, 0.f};
#pragma unroll
          for (int ks = 0; ks < 2; ++ks) {
            const bf16x8 kf = *(const bf16x8*)(Ks + (nt * 16 + fr) * 72 + ks * 32 + fq * 8);
            s[nt] = __builtin_amdgcn_mfma_f32_16x16x32_bf16(kf, qf[mt][ks], s[nt], 0, 0, 0);
          }
        }
        const int tq = q0 + mt * 16 + fr;
        float mx = -1e30f;
#pragma unroll
        for (int nt = 0; nt < 2; ++nt)
#pragma unroll
          for (int j = 0; j < 4; ++j) {
            const int tk = kb + nt * 16 + fq * 4 + j; const int dist = tq > tk ? tq - tk : tk - tq;
            const float sc = dist <= 128 ? s[nt][j] * 0.125f - slope * (float)dist : -1e30f;
            s[nt][j] = sc; mx = fmaxf(mx, sc);
          }
        mx = fmaxf(mx, __shfl_xor(mx, 16)); mx = fmaxf(mx, __shfl_xor(mx, 32));
        const float mnew = fmaxf(mrun[mt], mx), alpha = __expf(mrun[mt] - mnew);
        mrun[mt] = mnew;
        float ls = 0.f;
#pragma unroll
        for (int nt = 0; nt < 2; ++nt)
#pragma unroll
          for (int j = 0; j < 4; ++j) { const float pe = __expf(s[nt][j] - mnew); s[nt][j] = pe; ls += pe; }
        lrun[mt] = lrun[mt] * alpha + ls;
#pragma unroll
        for (int dt = 0; dt < 4; ++dt) o[dt][mt] = o[dt][mt] * alpha;
        u32x4 pu; pu.x = pk2(s[0][0], s[0][1]); pu.y = pk2(s[0][2], s[0][3]); pu.z = pk2(s[1][0], s[1][1]); pu.w = pk2(s[1][2], s[1][3]);
        const bf16x8 pf = __builtin_bit_cast(bf16x8, pu);
#pragma unroll
        for (int dt = 0; dt < 4; ++dt) {
          const bf16_t* vrow = Vt + (dt * 16 + fr) * 36 + fq * 4;
          u32x4 vu; const u32x2 v0 = *(const u32x2*)(vrow), v1 = *(const u32x2*)(vrow + 16);
          vu.x = v0.x; vu.y = v0.y; vu.z = v1.x; vu.w = v1.y;
          o[dt][mt] = __builtin_amdgcn_mfma_f32_16x16x32_bf16(__builtin_bit_cast(bf16x8, vu), pf, o[dt][mt], 0, 0, 0);
        }
      }
    }
#pragma unroll
    for (int mt = 0; mt < 2; ++mt) {
      float l = lrun[mt]; l += __shfl_xor(l, 16); l += __shfl_xor(l, 32);
      const float inv = 1.f / l;
#pragma unroll
      for (int dt = 0; dt < 4; ++dt) store4(oatt + (size_t)(q0 + mt * 16 + fr) * QKVW + h * 64 + dt * 16 + fq * 4, o[dt][mt] * inv);
    }
  }
}


DI void phase_attn_wave(const Params& p, unsigned char* ldsw, int first, int stride) {
  unsigned char* ws = p.ws;
  const bf16_t* qkv = (const bf16_t*)(ws + OFF_QKV);
  bf16_t* oatt = (bf16_t*)(ws + OFF_QKV);
  const int lane = threadIdx.x & 63, fr = lane & 15, fq = lane >> 4;
  bf16_t* Ks = (bf16_t*)ldsw;
  bf16_t* Vt = (bf16_t*)(ldsw + 4608);
  const int njobs = (M_TOK / 32) * 8;
  for (int job = first; job < njobs; job += stride) {
    const int q0 = (job >> 3) * 32, h = job & 7, kvh = h >> 2;
    int start, T; seq_of(q0, start, T);
    const float slope = exp2f(-(float)(h + 1)), sink = p.in[7][h];
    bf16x8 qf[2][2];
#pragma unroll
    for (int mt = 0; mt < 2; ++mt)
#pragma unroll
      for (int ks = 0; ks < 2; ++ks) qf[mt][ks] = *(const bf16x8*)(qkv + (size_t)(q0 + mt * 16 + fr) * QKVW + h * 64 + ks * 32 + fq * 8);
    f32x4 o[4][2];
#pragma unroll
    for (int a = 0; a < 4; ++a)
#pragma unroll
      for (int b = 0; b < 2; ++b) o[a][b] = (f32x4){0.f, 0.f, 0.f, 0.f};
    float mrun[2], lrun[2];
#pragma unroll
    for (int mt = 0; mt < 2; ++mt) { mrun[mt] = sink; lrun[mt] = fq == 0 ? 1.f : 0.f; }
#pragma unroll 1
    for (int kt = 0; kt < 9; ++kt) {
      const int kb = q0 - 128 + kt * 32, kbr = kb - start;
      if (kbr < 128 || kbr >= T + 128) continue;
      const bool phantom = kbr >= T;
      asm volatile("" ::: "memory");
#pragma unroll
      for (int i = 0; i < 4; ++i) {
        const int c = lane + 64 * i, key = c >> 3, dc = c & 7;
        const bf16_t* src = qkv + (size_t)(kb + key) * QKVW + 512 + kvh * 64 + dc * 8;
        u32x4 kvv = {0u, 0u, 0u, 0u}, vv = {0u, 0u, 0u, 0u};
        if (!phantom) { kvv = *(const u32x4*)src; vv = *(const u32x4*)(src + 128); }
        *(u32x4*)(Ks + key * 72 + dc * 8) = kvv;
        const unsigned w[4] = {vv.x, vv.y, vv.z, vv.w};
#pragma unroll
        for (int e = 0; e < 4; ++e) { Vt[(dc * 8 + 2 * e) * 36 + key] = (bf16_t)(w[e] & 0xffffu); Vt[(dc * 8 + 2 * e + 1) * 36 + key] = (bf16_t)(w[e] >> 16); }
      }
      asm volatile("s_waitcnt lgkmcnt(0)" ::: "memory");
#pragma unroll
      for (int mt = 0; mt < 2; ++mt) {
        f32x4 s[2];
#pragma unroll
        for (int nt = 0; nt < 2; ++nt) {
          s[nt] = (f32x4){0.f, 0.f, 0.f, 0.f};
#pragma unroll
          for (int ks = 0; ks < 2; ++ks) {
            const bf16x8 kf = *(const bf16x8*)(Ks + (nt * 16 + fr) * 72 + ks * 32 + fq * 8);
            s[nt] = __builtin_amdgcn_mfma_f32_16x16x32_bf16(kf, qf[mt][ks], s[nt], 0, 0, 0);
          }
        }
        const int tq = q0 + mt * 16 + fr;
        float mx = -1e30f;
#pragma unroll
        for (int nt = 0; nt < 2; ++nt)
#pragma unroll
          for (int j = 0; j < 4; ++j) {
            const int tk = kb + nt * 16 + fq * 4 + j; const int dist = tq > tk ? tq - tk : tk - tq;
            const float sc = dist <= 128 ? s[nt][j] * 0.125f - slope * (float)dist : -1e30f;
            s[nt][j] = sc; mx = fmaxf(mx, sc);
          }
        mx = fmaxf(mx, __shfl_xor(mx, 16)); mx = fmaxf(mx, __shfl_xor(mx, 32));
        const float mnew = fmaxf(mrun[mt], mx), alpha = __expf(mrun[mt] - mnew);
        mrun[mt] = mnew;
        float ls = 0.f;
#pragma unroll
        for (int nt = 0; nt < 2; ++nt)
#pragma unroll
          for (int j = 0; j < 4; ++j) { const float pe = __expf(s[nt][j] - mnew); s[nt][j] = pe; ls += pe; }
        lrun[mt] = lrun[mt] * alpha + ls;
#pragma unroll
        for (int dt = 0; dt < 4; ++dt) o[dt][mt] = o[dt][mt] * alpha;
        u32x4 pu; pu.x = pk2(s[0][0], s[0][1]); pu.y = pk2(s[0][2], s[0][3]); pu.z = pk2(s[1][0], s[1][1]); pu.w = pk2(s[1][2], s[1][3]);
        const bf16x8 pf = __builtin_bit_cast(bf16x8, pu);
#pragma unroll
        for (int dt = 0; dt < 4; ++dt) {
          const bf16_t* vrow = Vt + (dt * 16 + fr) * 36 + fq * 4;
          u32x4 vu; const u32x2 v0 = *(const u32x2*)(vrow), v1 = *(const u32x2*)(vrow + 16);
          vu.x = v0.x; vu.y = v0.y; vu.z = v1.x; vu.w = v1.y;
          o[dt][mt] = __builtin_amdgcn_mfma_f32_16x16x32_bf16(__builtin_bit_cast(bf16x8, vu), pf, o[dt][mt], 0, 0, 0);
        }
      }
    }
#pragma unroll
    for (int mt = 0; mt < 2; ++mt) {
      float l = lrun[mt]; l += __shfl_xor(l, 16); l += __shfl_xor(l, 32);
      const float inv = 1.f / l;
#pragma unroll
      for (int dt = 0; dt < 4; ++dt) store4(oatt + (size_t)(q0 + mt * 16 + fr) * QKVW + h * 64 + dt * 16 + fq * 4, o[dt][mt] * inv);
    }
  }
}

#ifndef NAIVE_ATTN
#define NAIVE_ATTN 0
#endif
#ifndef NAIVE_SCAN
#define NAIVE_SCAN 0
#endif
DI void phase_attn_naive(const Params& p) {
  unsigned char* ws = p.ws;
  const bf16_t* qkv = (const bf16_t*)(ws + OFF_QKV);
  bf16_t* oatt = (bf16_t*)(ws + OFF_QKV);
  const int lane = threadIdx.x & 63, gw = blockIdx.x * NWV + (threadIdx.x >> 6), nw = gridDim.x * NWV;
  for (int item = gw; item < M_TOK * 8; item += nw) {
    const int row = item >> 3, h = item & 7, kvh = h >> 2;
    int start, T; seq_of(row, start, T);
    const float slope = exp2f(-(float)(h + 1)), sink = p.in[7][h];
    const float q = bf2f(qkv[(size_t)row * QKVW + h * 64 + lane]);
    const int lo = max(row - 128, start + 128), hi = min(row + 128, start + T + 127);
    float m = sink, l = 1.f, acc = 0.f;
    for (int s = lo; s <= hi; ++s) {
      const bool real = s < start + T;
      const float kx = real ? bf2f(qkv[(size_t)s * QKVW + 512 + kvh * 64 + lane]) : 0.f;
      const float vx = real ? bf2f(qkv[(size_t)s * QKVW + 640 + kvh * 64 + lane]) : 0.f;
      const int dist = row > s ? row - s : s - row;
      const float sc = wave_sum(q * kx) * 0.125f - slope * (float)dist;
      const float mnew = fmaxf(m, sc), alpha = __expf(m - mnew), pe = __expf(sc - mnew);
      l = l * alpha + pe; acc = acc * alpha + pe * vx; m = mnew;
    }
    oatt[(size_t)row * QKVW + h * 64 + lane] = (bf16_t)(pk2(acc / l, 0.f) & 0xffffu);
  }
}
DI void phase_scan_naive(const Params& p) {
  unsigned char* ws = p.ws;
  const bf16_t* R = (const bf16_t*)(ws + OFF_R); const bf16_t* V = (const bf16_t*)(ws + OFF_V); const bf16_t* NKK = (const bf16_t*)(ws + OFF_NKK);
  const int wid = threadIdx.x >> 6, lane = threadIdx.x & 63;
  for (int chain = wid * gridDim.x + blockIdx.x; chain < 33 * 16; chain += 4 * gridDim.x) {
    const int seq = chain >> 4, hd = chain & 15, h = hd >> 1, d = hd & 1;
    const int start = seq == 0 ? 0 : T_P + (seq - 1) * T_S, T = seq == 0 ? T_P : T_S;
    const bf16_t* Wd = (const bf16_t*)((const unsigned char*)p.out + (size_t)d * SEG);
    const bf16_t* Kd = (const bf16_t*)((const unsigned char*)p.out + (size_t)(2 + d) * SEG);
    const bf16_t* Bd = (const bf16_t*)(ws + OFF_BF + (size_t)d * SEG);
    bf16_t* YS = (bf16_t*)(ws + OFF_YS + (size_t)d * SEG);
    float S[64];
#pragma unroll
    for (int j = 0; j < 64; ++j) S[j] = 0.f;
    for (int i = 0; i < T; ++i) {
      const int t = d ? T - 1 - i : i; const size_t o = (size_t)(start + t) * RWW + h * 64;
      const float v = bf2f(V[o + lane]);
      float sa = 0.f;
#pragma unroll
      for (int c = 0; c < 8; ++c) { float a[8]; unpack8(*(const u32x4*)(NKK + o + c * 8), a);
#pragma unroll
        for (int e = 0; e < 8; ++e) sa += S[c * 8 + e] * a[e]; }
      float y = 0.f;
#pragma unroll
      for (int c = 0; c < 8; ++c) { float w[8], k[8], b[8], r[8];
        unpack8(*(const u32x4*)(Wd + o + c * 8), w); unpack8(*(const u32x4*)(Kd + o + c * 8), k); unpack8(*(const u32x4*)(Bd + o + c * 8), b); unpack8(*(const u32x4*)(R + o + c * 8), r);
#pragma unroll
        for (int e = 0; e < 8; ++e) { const float sn = S[c * 8 + e] * (1.f - w[e]) + sa * b[e] + v * k[e]; S[c * 8 + e] = sn; y += sn * r[e]; } }
      YS[o + lane] = (bf16_t)(pk2(y, 0.f) & 0xffffu);
    }
  }
}
DI void phase_row_h(const Params& p) {
  unsigned char* ws = p.ws;
  const bf16_t* MO = (const bf16_t*)(ws + OFF_MO); bf16_t* HB = (bf16_t*)(ws + OFF_HB); float* rstdh = (float*)(ws + OFF_RSTDH);
  const float* g = p.in[3];
  const int lane = threadIdx.x & 63, gw = blockIdx.x * NWV + (threadIdx.x >> 6), nw = gridDim.x * NWV;
  for (int row = gw; row < M_TOK; row += nw) {
    const float* xs = row < T_P ? p.in[0] + (size_t)row * DM : p.in[1] + (size_t)(row - T_P) * DM;
    float m[16]; float ss = 0.f;
#pragma unroll
    for (int i = 0; i < 2; ++i) unpack8(*(const u32x4*)(MO + (size_t)row * DM + i * 512 + lane * 8), m + i * 8);
#pragma unroll
    for (int e = 0; e < 16; ++e) ss += m[e] * m[e];
    ss = wave_sum(ss);
    const float rs = rsqrtf(ss * (1.f / DM) + 1e-6f);
    float hs = 0.f; float hv[16];
#pragma unroll
    for (int i = 0; i < 2; ++i)
#pragma unroll
      for (int q = 0; q < 2; ++q) {
        const int c = i * 512 + lane * 8 + q * 4;
        const f32x4 xv = *(const f32x4*)(xs + c), gv = *(const f32x4*)(g + c);
        f32x4 hh;
#pragma unroll
        for (int e = 0; e < 4; ++e) { hh[e] = xv[e] + m[i * 8 + q * 4 + e] * rs * gv[e]; hv[i * 8 + q * 4 + e] = hh[e]; hs += hh[e] * hh[e]; }
        *(f32x4*)(p.out + (size_t)row * DM + c) = hh;
      }
#pragma unroll
    for (int i = 0; i < 2; ++i) *(u32x4*)(HB + (size_t)row * DM + i * 512 + lane * 8) = pack8(hv + i * 8);
    hs = wave_sum(hs);
    if (lane == 0) rstdh[row] = rsqrtf(hs * (1.f / DM) + 1e-6f);
  }
}
DI void phase_row_out(const Params& p) {
  unsigned char* ws = p.ws;
  const bf16_t* F = (const bf16_t*)(ws + OFF_F);
  const float* g = p.in[5];
  const int lane = threadIdx.x & 63, gw = blockIdx.x * NWV + (threadIdx.x >> 6), nw = gridDim.x * NWV;
  for (int row = gw; row < M_TOK; row += nw) {
    float m[16]; float ss = 0.f;
#pragma unroll
    for (int i = 0; i < 2; ++i) unpack8(*(const u32x4*)(F + (size_t)row * DM + i * 512 + lane * 8), m + i * 8);
#pragma unroll
    for (int e = 0; e < 16; ++e) ss += m[e] * m[e];
    ss = wave_sum(ss);
    const float rs = rsqrtf(ss * (1.f / DM) + 1e-6f);
#pragma unroll
    for (int i = 0; i < 2; ++i)
#pragma unroll
      for (int q = 0; q < 2; ++q) {
        const int c = i * 512 + lane * 8 + q * 4;
        float* op = p.out + (size_t)row * DM + c;
        const f32x4 hv = *(const f32x4*)op, gv = *(const f32x4*)(g + c);
        f32x4 r;
#pragma unroll
        for (int e = 0; e < 4; ++e) r[e] = hv[e] + m[i * 8 + q * 4 + e] * rs * gv[e];
        *(f32x4*)op = r;
      }
  }
}
DI void phase_convglu(const Params& p, int hf) {
  unsigned char* ws = p.ws;
  const bf16_t* HUP = (const bf16_t*)(ws + OFF_HUP); bf16_t* ACT = (bf16_t*)(ws + (hf ? OFF_ACT1 : OFF_ACT));
  const float* cw = p.in[24]; const float* cbias = p.in[25];
  constexpr int RB = 16, NCHK = DFF / 8;
  const int total = (HALF_ROWS / RB) * NCHK;
  for (int idx = blockIdx.x * NTHR + threadIdx.x; idx < total; idx += gridDim.x * NTHR) {
    const int rbk = idx / NCHK, c = (idx % NCHK) * 8, lr0 = rbk * RB, row0 = hf * HALF_ROWS + lr0;
    int start, T; seq_of(row0, start, T);
    const int pos0 = row0 - start;
    float w[2][3][8], bs[2][8];
#pragma unroll
    for (int part = 0; part < 2; ++part) {
#pragma unroll
      for (int d = 0; d < 3; ++d) {
        const f32x4 a = *(const f32x4*)(cw + d * 2 * DFF + part * DFF + c), b = *(const f32x4*)(cw + d * 2 * DFF + part * DFF + c + 4);
        w[part][d][0] = a.x; w[part][d][1] = a.y; w[part][d][2] = a.z; w[part][d][3] = a.w; w[part][d][4] = b.x; w[part][d][5] = b.y; w[part][d][6] = b.z; w[part][d][7] = b.w;
      }
      const f32x4 a = *(const f32x4*)(cbias + part * DFF + c), b = *(const f32x4*)(cbias + part * DFF + c + 4);
      bs[part][0] = a.x; bs[part][1] = a.y; bs[part][2] = a.z; bs[part][3] = a.w; bs[part][4] = b.x; bs[part][5] = b.y; bs[part][6] = b.z; bs[part][7] = b.w;
    }
    const bf16_t* hp = HUP + (size_t)lr0 * (2 * DFF) + c;
    float prev[2][8], cur[2][8], nxt[2][8];
#pragma unroll
    for (int part = 0; part < 2; ++part) {
      if (pos0 > 0) unpack8(*(const u32x4*)(hp - 2 * DFF + part * DFF), prev[part]); else { for (int e = 0; e < 8; ++e) prev[part][e] = 0.f; }
      unpack8(*(const u32x4*)(hp + part * DFF), cur[part]);
    }
#pragma unroll
    for (int r = 0; r < RB; ++r) {
      const bool hasn = pos0 + r < T - 1;
#pragma unroll
      for (int part = 0; part < 2; ++part) {
        if (hasn) unpack8(*(const u32x4*)(hp + (size_t)(r + 1) * (2 * DFF) + part * DFF), nxt[part]); else { for (int e = 0; e < 8; ++e) nxt[part][e] = 0.f; }
      }
      float o[8];
#pragma unroll
      for (int e = 0; e < 8; ++e) {
        const float x = prev[0][e] * w[0][0][e] + cur[0][e] * w[0][1][e] + nxt[0][e] * w[0][2][e] + bs[0][e];
        const float up = prev[1][e] * w[1][0][e] + cur[1][e] * w[1][1][e] + nxt[1][e] * w[1][2][e] + bs[1][e];
        const float u = 0.7978845608028654f * (x + 0.044715f * x * x * x);
        const float t2 = __expf(2.f * u); const float th = 1.f - 2.f / (t2 + 1.f);
        o[e] = 0.5f * x * (1.f + th) * up;
      }
      *(u32x4*)(ACT + (size_t)(lr0 + r) * DFF + c) = pack8(o);
#pragma unroll
      for (int part = 0; part < 2; ++part)
#pragma unroll
        for (int e = 0; e < 8; ++e) { prev[part][e] = cur[part][e]; cur[part][e] = nxt[part][e]; }
    }
  }
}

constexpr int NPHASE = 18;
constexpr int LDS_BYTES = 2 * STAGE8;
static_assert(LDS_BYTES >= 2 * 64 * 65 * 4 && LDS_BYTES >= 9216 + 64 * 68 * 2, "lds");

template <int PH>
DI void run_phase(const Params& p, unsigned char* lds) {
  unsigned char* ws = p.ws;
  if constexpr (PH == 0) phase_prep(p, lds);
  else if constexpr (PH == 1) { EpiScaleStore e{(bf16_t*)p.out, ZLD, (const float*)(ws + OFF_RSTDX), 0};
    gemm_phase((const bf16_t*)(ws + OFF_XB), DM, (const bf16_t*)(ws + OFF_WZT), DM, DM, 0, M_TOK, ZLD, lds, e); }
  else if constexpr (PH == 2) phase_rwprep(p);
  else if constexpr (PH == 3) {
#pragma unroll 1
    for (int d = 0; d < 2; ++d) {
      EpiW ew{(bf16_t*)((unsigned char*)p.out + (size_t)d * SEG), p.in[10] + d * 512};
      gemm_phase((const bf16_t*)(ws + OFF_LIN) + d * 64, LINW, (const bf16_t*)(ws + OFF_W2T) + d * 512 * 64, 64, 64, 0, M_TOK, RWW, lds, ew, d * 128);
      EpiA ea{(bf16_t*)((unsigned char*)p.out + (size_t)(2 + d) * SEG), (bf16_t*)(ws + OFF_BF + (size_t)d * SEG), (const bf16_t*)(ws + OFF_KSH),
              (const bf16_t*)(ws + OFF_NKK), p.in[12] + d * 512, p.in[16]};
      gemm_phase((const bf16_t*)(ws + OFF_LIN) + 128 + d * 64, LINW, (const bf16_t*)(ws + OFF_A2T) + d * 512 * 64, 64, 64, 0, M_TOK, RWW, lds, ea, 128 - d * 128);
    }
    EpiStore eg{(bf16_t*)(ws + OFF_G), RWW};
    gemm_phase((const bf16_t*)(ws + OFF_LIN) + 256, LINW, (const bf16_t*)(ws + OFF_G2T), 160, 160, 0, M_TOK, RWW, lds, eg);
  }
  else if constexpr (PH == 4) { EpiQG e{(bf16_t*)(ws + OFF_QKV), nullptr, (const float*)(ws + OFF_RSTDX)};
    gemm_phase((const bf16_t*)(ws + OFF_XB), DM, (const bf16_t*)(ws + OFF_WQGT), DM, DM, 0, M_TOK, QKVW, lds, e); }
  else if constexpr (PH == 5) {
    const int wid = threadIdx.x >> 6;
    if (wid < 3) phase_scan(p, lds);
    else phase_attn_wave(p, lds + 3 * SCAN_WLDS + (wid - 3) * 9216, (int)blockIdx.x * 5 + (wid - 3), (int)gridDim.x * 5);
  }
  else if constexpr (PH == 6) phase_scan_fix(p, lds);
  else if constexpr (PH == 7) phase_rwfinish(p);
  else if constexpr (PH == 8) { EpiGate e{(bf16_t*)(ws + OFF_SG), (const float*)(ws + OFF_RSTDX)};
    gemm_phase((const bf16_t*)(ws + OFF_XB), DM, (const bf16_t*)(ws + OFF_WQGT) + (size_t)QKVW * DM, DM, DM, 0, M_TOK, SGW, lds, e); }
  else if constexpr (PH == 9) {
    EpiMerge1 e1{(bf16_t*)(ws + OFF_MERGED), (const bf16_t*)(ws + OFF_SG)};
    EpiMerge2 e2{(bf16_t*)(ws + OFF_MERGED), (const bf16_t*)(ws + OFF_SG)};
    const int ntn = DM / T8, ntm = M_TOK / T8;
    for (int t = blockIdx.x; t < ntn * ntm; t += gridDim.x) {
      int tm, tn; tile_of(t, ntm, ntn, tm, tn);
      gemm_tile8((const bf16_t*)(ws + OFF_QKV), QKVW, (const bf16_t*)(ws + OFF_WAT), 512, 512, tm * T8, tn * T8, lds, e1);
    }
    asm volatile("" ::: "memory");
    for (int t = blockIdx.x; t < ntn * ntm; t += gridDim.x) {
      int tm, tn; tile_of(t, ntm, ntn, tm, tn);
      gemm_tile8((const bf16_t*)p.out, 512, (const bf16_t*)(ws + OFF_WBT), 512, 512, tm * T8, tn * T8, lds, e2);
    }
  }
  else if constexpr (PH == 10) { EpiStore e{(bf16_t*)(ws + OFF_MO), DM};
    gemm_phase((const bf16_t*)(ws + OFF_MERGED), DM, (const bf16_t*)(ws + OFF_WOT), DM, DM, 0, M_TOK, DM, lds, e); }
  else if constexpr (PH == 11) phase_row_h(p);
  else if constexpr (PH == 12 || PH == 14) { constexpr int hf = PH == 12 ? 0 : 1;
    EpiScaleStore e{(bf16_t*)(ws + OFF_HUP), 2 * DFF, (const float*)(ws + OFF_RSTDH), hf * HALF_ROWS};
    gemm_phase((const bf16_t*)(ws + OFF_HB), DM, (const bf16_t*)(ws + OFF_WUPT), DM, DM, hf * HALF_ROWS, HALF_ROWS, 2 * DFF, lds, e); }
  else if constexpr (PH == 13 || PH == 15) phase_convglu(p, PH == 13 ? 0 : 1);
  else if constexpr (PH == 16) {
    EpiStore e{(bf16_t*)(ws + OFF_F), DM};
    const bf16_t* A0 = (const bf16_t*)(ws + OFF_ACT);
    const bf16_t* A1 = (const bf16_t*)(ws + OFF_ACT1) - (size_t)HALF_ROWS * DFF;
    const int ntn = DM / T8, ntm = M_TOK / T8;
    for (int t = blockIdx.x; t < ntn * ntm; t += gridDim.x) {
      int tm, tn; tile_of(t, ntm, ntn, tm, tn);
      gemm_tile8(tm * T8 < HALF_ROWS ? A0 : A1, DFF, (const bf16_t*)(ws + OFF_WDNT), DFF, DFF, tm * T8, tn * T8, lds, e);
    }
  }
  else if constexpr (PH == 17) phase_row_out(p);
}

constexpr size_t OFF_BAR = 1016 * MBY;
DI void grid_barrier(const Params& p, int k) {
  __syncthreads();
  if (threadIdx.x == 0) {
    unsigned* base = (unsigned*)(p.ws + OFF_BAR);
    const int g = blockIdx.x & 7, G = gridDim.x, ng = (G - g + 7) >> 3;
    const unsigned ngroups = G < 8 ? G : 8;
    __builtin_amdgcn_fence(__ATOMIC_RELEASE, "agent");
    const unsigned old = __hip_atomic_fetch_add(base + g * 64, 1u, __ATOMIC_RELAXED, __HIP_MEMORY_SCOPE_AGENT);
    if (old + 1 == (unsigned)(k * ng)) __hip_atomic_fetch_add(base + 8 * 64, 1u, __ATOMIC_RELAXED, __HIP_MEMORY_SCOPE_AGENT);
    while (__hip_atomic_load(base + 8 * 64, __ATOMIC_RELAXED, __HIP_MEMORY_SCOPE_AGENT) < (unsigned)k * ngroups) __builtin_amdgcn_s_sleep(1);
    __builtin_amdgcn_fence(__ATOMIC_ACQUIRE, "agent");
  }
  __syncthreads();
}

template <int PH>
DI void run_all(const Params& p, unsigned char* lds) {
  run_phase<PH>(p, lds);
  if constexpr (((DUP_MASK >> PH) & 1) != 0) { __syncthreads(); run_phase<PH>(p, lds); }
  if constexpr (PH + 1 < NPHASE) {
    if constexpr (PH == 0) cg::this_grid().sync();
    else grid_barrier(p, PH);
    run_all<PH + 1>(p, lds);
  }
}

__global__ void __launch_bounds__(512) mega_coop(Params p) {
  __shared__ __attribute__((aligned(16))) unsigned char lds[LDS_BYTES];
  if (blockIdx.x == 0 && threadIdx.x < 16) __hip_atomic_store((unsigned*)(p.ws + OFF_BAR) + threadIdx.x * 64, 0u, __ATOMIC_RELAXED, __HIP_MEMORY_SCOPE_AGENT);
  run_all<0>(p, lds);
}

template <int PH>
__global__ void __launch_bounds__(512) mega_one(Params p) {
  __shared__ __attribute__((aligned(16))) unsigned char lds[LDS_BYTES];
  run_phase<PH>(p, lds);
}

template <int PH>
static void launch_all(const Params& p, int grid, hipStream_t stream) {
  hipLaunchKernelGGL(mega_one<PH>, dim3(grid), dim3(NTHR), 0, stream, p);
  if constexpr (PH + 1 < NPHASE) launch_all<PH + 1>(p, grid, stream);
}

extern "C" void kernel_launch(void* const* d_in, const int* in_sizes, int n_in, void* d_out, int out_size, void* d_ws, size_t ws_size,
                              hipStream_t stream) {
  static int grid_blocks = 0;
  if (!grid_blocks) {
    int dev = 0, cus = 0, per_cu = 0;
    (void)hipGetDevice(&dev);
    (void)hipDeviceGetAttribute(&cus, hipDeviceAttributeMultiprocessorCount, dev);
    (void)hipOccupancyMaxActiveBlocksPerMultiprocessor(&per_cu, mega_coop, NTHR, 0);
    if (per_cu < 1) per_cu = 1;
    if (per_cu > 1) per_cu = 1;
    grid_blocks = cus * per_cu;
    if (ws_size < 1014 * MBY) fprintf(stderr, "kernel_launch: workspace too small (%zu)\n", ws_size);
  }
  Params p{};
  for (int i = 0; i < 27; ++i) p.in[i] = (const float*)d_in[i];
  p.out = (float*)d_out; p.ws = (unsigned char*)d_ws;
  if (COOP_MODE) {
    void* args[] = {&p};
    hipError_t e = hipLaunchCooperativeKernel((void*)mega_coop, dim3(grid_blocks), dim3(NTHR), args, 0, stream);
    if (e != hipSuccess) fprintf(stderr, "cooperative launch failed: %s (grid %d)\n", hipGetErrorString(e), grid_blocks);
  } else {
    launch_all<0>(p, grid_blocks, stream);
  }
}
```

```cpp
#include <hip/hip_runtime.h>
#include <hip/hip_cooperative_groups.h>
#include <cstdint>
#include <cstdio>
namespace cg = cooperative_groups;

#ifndef NAIVE_GEMM
#define NAIVE_GEMM 0
#endif
#ifndef NAIVE_TR
#define NAIVE_TR 0
#endif
#ifndef DUP_MASK
#define DUP_MASK 0
#endif
#ifndef COOP_MODE
#define COOP_MODE 1
#endif

typedef unsigned short bf16_t;
typedef short bf16x8 __attribute__((ext_vector_type(8)));
typedef short s16x4 __attribute__((ext_vector_type(4)));
typedef float f32x4 __attribute__((ext_vector_type(4)));
typedef float f32x2 __attribute__((ext_vector_type(2)));
typedef unsigned u32x4 __attribute__((ext_vector_type(4)));
typedef unsigned u32x2 __attribute__((ext_vector_type(2)));
typedef __bf16 bf16x2_t __attribute__((ext_vector_type(2)));
#define DI __device__ __forceinline__

constexpr int M_TOK = 81920, DM = 1024, T_P = 16384, T_S = 2048;
constexpr int IN_W = 4768, RWW = 512, DFF = 2816, ZW = 1952, ZLD = 2048, LINW = 416, QKVW = 768, SGW = 2048;
constexpr int HALF_ROWS = 40960;
constexpr int NTHR = 512, NWV = NTHR / 64;
constexpr size_t MBY = 1ull << 20;
constexpr size_t OFF_WZT = 0, OFF_WQGT = 4 * MBY, OFF_WAT = OFF_WQGT + 2816ull * 1024 * 2, OFF_WBT = OFF_WAT + MBY, OFF_WOT = OFF_WBT + MBY,
                 OFF_WUPT = OFF_WOT + 2 * MBY, OFF_WDNT = OFF_WUPT + 11 * MBY, OFF_W2T = 30 * MBY, OFF_A2T = OFF_W2T + 128 * 1024,
                 OFF_G2T = OFF_A2T + 128 * 1024;
constexpr size_t OFF_RSTDX = 32 * MBY, OFF_RSTDH = 33 * MBY;
constexpr size_t OFF_XB = 34 * MBY;
constexpr size_t OFF_R = 194 * MBY, OFF_V = 274 * MBY, OFF_NKK = 354 * MBY, OFF_BF = 434 * MBY  ;
constexpr size_t OFF_KSH = 594 * MBY, OFF_LIN = 674 * MBY, OFF_G = 739 * MBY, OFF_YS = 819 * MBY  ;
constexpr size_t OFF_QKV = 594 * MBY  , OFF_MERGED = 714 * MBY  , OFF_SG = 194 * MBY  ;
constexpr size_t OFF_MO = OFF_XB, OFF_HB = 194 * MBY, OFF_HUP = 354 * MBY  , OFF_ACT = 794 * MBY  , OFF_ACT1 = 34 * MBY  , OFF_F = 354 * MBY  ;
constexpr size_t SEG = (size_t)M_TOK * 512 * 2;

struct Params { const float* in[27]; float* out; unsigned char* ws; };

DI unsigned pk2(float lo, float hi) { f32x2 v = {lo, hi}; bf16x2_t b = __builtin_convertvector(v, bf16x2_t); return __builtin_bit_cast(unsigned, b); }
DI float lo2f(unsigned u) { return __uint_as_float(u << 16); }
DI float hi2f(unsigned u) { return __uint_as_float(u & 0xffff0000u); }
DI float bf2f(bf16_t v) { return __uint_as_float(((unsigned)v) << 16); }
DI void unpack8(const u32x4 u, float* f) { f[0] = lo2f(u.x); f[1] = hi2f(u.x); f[2] = lo2f(u.y); f[3] = hi2f(u.y); f[4] = lo2f(u.z); f[5] = hi2f(u.z); f[6] = lo2f(u.w); f[7] = hi2f(u.w); }
DI u32x4 pack8(const float* f) { u32x4 u; u.x = pk2(f[0], f[1]); u.y = pk2(f[2], f[3]); u.z = pk2(f[4], f[5]); u.w = pk2(f[6], f[7]); return u; }
DI float sigmoidf_(float x) { return 1.f / (1.f + __expf(-x)); }
DI float wave_sum(float v) {
#pragma unroll
  for (int o = 32; o >= 1; o >>= 1) v += __shfl_xor(v, o);
  return v;
}
DI void seq_of(int row, int& start, int& T) { if (row < T_P) { start = 0; T = T_P; } else { start = T_P + ((row - T_P) / T_S) * T_S; T = T_S; } }

DI void transpose_job(const float* __restrict__ src, int srcN, int K, int n0, int ncols, int ncols_pad, bf16_t* __restrict__ dst,
                              const float* __restrict__ scale, float* lds) {
  const int ntn = (ncols_pad + 63) / 64, ntk = (K + 63) / 64, tid = threadIdx.x;
  if (NAIVE_TR) {
    for (size_t idx = (size_t)blockIdx.x * NTHR + tid; idx < (size_t)ncols_pad * K; idx += (size_t)gridDim.x * NTHR) {
      const int n = (int)(idx / K), k = (int)(idx % K);
      float v = 0.f;
      if (n < ncols) { v = src[(size_t)k * srcN + n0 + n]; if (scale) v *= scale[k]; }
      dst[idx] = (bf16_t)(pk2(v, 0.f) & 0xffffu);
    }
    return;
  }
  for (int t = blockIdx.x; t < ntn * ntk; t += gridDim.x) {
    const int tk = t % ntk, tn = t / ntk;
#pragma unroll
    for (int i = 0; i < 64 / NWV; ++i) {
      const int kk = i * NWV + (tid >> 6), nn = tid & 63, k = tk * 64 + kk, n = tn * 64 + nn;
      float v = 0.f;
      if (k < K && n < ncols) { v = src[(size_t)k * srcN + n0 + n]; if (scale) v *= scale[k]; }
      lds[kk * 65 + nn] = v;
    }
    __syncthreads();
#pragma unroll
    for (int i = 0; i < 64 / NWV; ++i) {
      const int nn = i * NWV + (tid >> 6), kk = tid & 63, k = tk * 64 + kk, n = tn * 64 + nn;
      if (k < K && n < ncols_pad) { unsigned u = pk2(lds[kk * 65 + nn], 0.f); dst[(size_t)n * K + k] = (bf16_t)(u & 0xffffu); }
    }
    __syncthreads();
  }
}

DI void phase_prep(const Params& p, unsigned char* ldsb) {
  float* lds = (float*)ldsb;
  unsigned char* ws = p.ws;
  transpose_job(p.in[6], IN_W, 1024, 768, ZW, ZLD, (bf16_t*)(ws + OFF_WZT), p.in[2], lds);
  transpose_job(p.in[6], IN_W, 1024, 0, 768, 768, (bf16_t*)(ws + OFF_WQGT), p.in[2], lds);
  transpose_job(p.in[6], IN_W, 1024, 2720, 2048, 2048, (bf16_t*)(ws + OFF_WQGT) + 768 * 1024, p.in[2], lds);
  transpose_job(p.in[20], 1024, 512, 0, 1024, 1024, (bf16_t*)(ws + OFF_WAT), nullptr, lds);
  transpose_job(p.in[21], 1024, 512, 0, 1024, 1024, (bf16_t*)(ws + OFF_WBT), nullptr, lds);
  transpose_job(p.in[22], 1024, 1024, 0, 1024, 1024, (bf16_t*)(ws + OFF_WOT), nullptr, lds);
  transpose_job(p.in[23], 2 * DFF, 1024, 0, 2 * DFF, 2 * DFF, (bf16_t*)(ws + OFF_WUPT), p.in[4], lds);
  transpose_job(p.in[26], 1024, DFF, 0, 1024, 1024, (bf16_t*)(ws + OFF_WDNT), nullptr, lds);
  for (int d = 0; d < 2; ++d) {
    transpose_job(p.in[11] + d * 64 * 512, 512, 64, 0, 512, 512, (bf16_t*)(ws + OFF_W2T) + d * 512 * 64, nullptr, lds);
    transpose_job(p.in[13] + d * 64 * 512, 512, 64, 0, 512, 512, (bf16_t*)(ws + OFF_A2T) + d * 512 * 64, nullptr, lds);
  }
  transpose_job(p.in[14], 512, 160, 0, 512, 512, (bf16_t*)(ws + OFF_G2T), nullptr, lds);
  const int lane = threadIdx.x & 63, gw = blockIdx.x * NWV + (threadIdx.x >> 6), nw = gridDim.x * NWV;
  bf16_t* xb = (bf16_t*)(ws + OFF_XB);
  float* rstd = (float*)(ws + OFF_RSTDX);
  for (int row = gw; row < M_TOK; row += nw) {
    const float* src = row < T_P ? p.in[0] + (size_t)row * DM : p.in[1] + (size_t)(row - T_P) * DM;
    float ss = 0.f;
#pragma unroll
    for (int i = 0; i < 4; ++i) {
      const int c = (i * 64 + lane) * 4;
      const f32x4 v = *(const f32x4*)(src + c);
      ss += v.x * v.x + v.y * v.y + v.z * v.z + v.w * v.w;
      u32x2 o; o.x = pk2(v.x, v.y); o.y = pk2(v.z, v.w);
      *(u32x2*)(xb + (size_t)row * DM + c) = o;
    }
    ss = wave_sum(ss);
    if (lane == 0) rstd[row] = rsqrtf(ss * (1.f / DM) + 1e-6f);
  }
}

constexpr int LROW = 80;
template <int MT, int NT, class Epi>
DI void gemm_tile(const bf16_t* __restrict__ A, int lda, const bf16_t* __restrict__ Bt, int ldb, int K, int row0, int col0,
                  unsigned char* lds, Epi& epi) {
  constexpr int BM = 32 * MT, BN = 32 * NT, STAGE = (BM + BN) * LROW, ACH = BM * 4 / 256, BCH = BN * 4 / 256;
  const int tid = threadIdx.x, lane = tid & 63, wid = tid >> 6, wm = wid >> 1, wn = wid & 1, fr = lane & 15, fq = lane >> 4;
  f32x4 acc[MT][NT];
#pragma unroll
  for (int i = 0; i < MT; ++i)
#pragma unroll
    for (int j = 0; j < NT; ++j) acc[i][j] = (f32x4){0.f, 0.f, 0.f, 0.f};
  u32x4 ra[ACH], rb[BCH];
  const bf16_t* ap[ACH]; const bf16_t* bp[BCH];
#pragma unroll
  for (int i = 0; i < ACH; ++i) { const int c = tid + i * 256; ap[i] = A + (size_t)(row0 + (c >> 2)) * lda + (c & 3) * 8; }
#pragma unroll
  for (int i = 0; i < BCH; ++i) { const int c = tid + i * 256; bp[i] = Bt + (size_t)(col0 + (c >> 2)) * ldb + (c & 3) * 8; }
  const int nk = K / 32;
#pragma unroll
  for (int i = 0; i < ACH; ++i) ra[i] = *(const u32x4*)(ap[i]);
#pragma unroll
  for (int i = 0; i < BCH; ++i) rb[i] = *(const u32x4*)(bp[i]);
#pragma unroll
  for (int i = 0; i < ACH; ++i) { const int c = tid + i * 256; *(u32x4*)(lds + (c >> 2) * LROW + (c & 3) * 16) = ra[i]; }
#pragma unroll
  for (int i = 0; i < BCH; ++i) { const int c = tid + i * 256; *(u32x4*)(lds + BM * LROW + (c >> 2) * LROW + (c & 3) * 16) = rb[i]; }
  __syncthreads();
  for (int kt = 0; kt < nk; ++kt) {
    const bool more = kt + 1 < nk;
    if (more) {
#pragma unroll
      for (int i = 0; i < ACH; ++i) ra[i] = *(const u32x4*)(ap[i] + (kt + 1) * 32);
#pragma unroll
      for (int i = 0; i < BCH; ++i) rb[i] = *(const u32x4*)(bp[i] + (kt + 1) * 32);
    }
    const unsigned char* sa = lds + (kt & 1) * STAGE;
    const unsigned char* sb = sa + BM * LROW;
    bf16x8 af[MT], bfv[NT];
#pragma unroll
    for (int i = 0; i < MT; ++i) af[i] = *(const bf16x8*)(sa + (wm * MT * 16 + i * 16 + fr) * LROW + fq * 16);
#pragma unroll
    for (int j = 0; j < NT; ++j) bfv[j] = *(const bf16x8*)(sb + (wn * NT * 16 + j * 16 + fr) * LROW + fq * 16);
#pragma unroll
    for (int i = 0; i < MT; ++i)
#pragma unroll
      for (int j = 0; j < NT; ++j) acc[i][j] = __builtin_amdgcn_mfma_f32_16x16x32_bf16(bfv[j], af[i], acc[i][j], 0, 0, 0);
    if (more) {
      unsigned char* da = lds + ((kt + 1) & 1) * STAGE;
#pragma unroll
      for (int i = 0; i < ACH; ++i) { const int c = tid + i * 256; *(u32x4*)(da + (c >> 2) * LROW + (c & 3) * 16) = ra[i]; }
#pragma unroll
      for (int i = 0; i < BCH; ++i) { const int c = tid + i * 256; *(u32x4*)(da + BM * LROW + (c >> 2) * LROW + (c & 3) * 16) = rb[i]; }
    }
    __syncthreads();
  }
#pragma unroll
  for (int i = 0; i < MT; ++i)
#pragma unroll
    for (int j = 0; j < NT; ++j) epi(row0 + wm * MT * 16 + i * 16 + fr, col0 + wn * NT * 16 + j * 16 + fq * 4, acc[i][j]);
}


#ifndef NAIVE_GEMM
#define NAIVE_GEMM 0
#endif
#ifndef NAIVE_TR
#define NAIVE_TR 0
#endif
template <int MT, int NT, class Epi>
DI void gemm_tile_naive(const bf16_t* A, int lda, const bf16_t* Bt, int ldb, int K, int row0, int col0, Epi& epi) {
  const int tid = threadIdx.x, lane = tid & 63, wid = tid >> 6, wm = wid >> 1, wn = wid & 1, fr = lane & 15, fq = lane >> 4;
  for (int i = 0; i < MT; ++i)
    for (int j = 0; j < NT; ++j) {
      const int row = row0 + wm * MT * 16 + i * 16 + fr, col = col0 + wn * NT * 16 + j * 16 + fq * 4;
      f32x4 acc = {0.f, 0.f, 0.f, 0.f};
      for (int k = 0; k < K; k += 8) {
        float a[8]; unpack8(*(const u32x4*)(A + (size_t)row * lda + k), a);
#pragma unroll
        for (int jj = 0; jj < 4; ++jj) { float b[8]; unpack8(*(const u32x4*)(Bt + (size_t)(col + jj) * ldb + k), b);
#pragma unroll
          for (int e = 0; e < 8; ++e) acc[jj] += a[e] * b[e]; }
      }
      epi(row, col, acc);
    }
}
DI void store4(bf16_t* ptr, f32x4 v) { u32x2 o; o.x = pk2(v.x, v.y); o.y = pk2(v.z, v.w); *(u32x2*)ptr = o; }
DI f32x4 load4(const bf16_t* ptr) { const u32x2 u = *(const u32x2*)ptr; return (f32x4){lo2f(u.x), hi2f(u.x), lo2f(u.y), hi2f(u.y)}; }

constexpr int GMT = 8, GNT = 4, GBM = 32 * GMT, GBN = 32 * GNT;

struct EpiScaleStore { bf16_t* O; int ldo; const float* rstd; int rowoff;
  DI void operator()(int row, int col, f32x4 v) { const float s = rstd[row]; store4(O + (size_t)(row - rowoff) * ldo + col, v * s); } };
struct EpiQG { bf16_t* qkv; bf16_t* sg; const float* rstd;
  DI void operator()(int row, int col, f32x4 v) { const float s = rstd[row]; v = v * s;
    if (col < QKVW) store4(qkv + (size_t)row * QKVW + col, v);
    else { f32x4 g = {sigmoidf_(v.x), sigmoidf_(v.y), sigmoidf_(v.z), sigmoidf_(v.w)}; store4(sg + (size_t)row * SGW + (col - QKVW), g); } } };
struct EpiGate { bf16_t* sg; const float* rstd;
  DI void operator()(int row, int col, f32x4 v) { const float s = rstd[row]; v = v * s;
    f32x4 g = {sigmoidf_(v.x), sigmoidf_(v.y), sigmoidf_(v.z), sigmoidf_(v.w)}; store4(sg + (size_t)row * SGW + col, g); } };
struct EpiW { bf16_t* O; const float* w0;
  DI void operator()(int row, int col, f32x4 v) { f32x4 o;
#pragma unroll
    for (int j = 0; j < 4; ++j) { const float x = w0[col + j] + v[j]; const float sp = fmaxf(-x, 0.f) + __logf(1.f + __expf(-fabsf(x)));
      const float e = __expf(-sp - 0.5f); o[j] = 1.f - __expf(-e); }
    store4(O + (size_t)row * RWW + col, o); } };
struct EpiA { bf16_t* KO; bf16_t* BO; const bf16_t* ksh; const bf16_t* nkk; const float* a0; const float* k_a;
  DI void operator()(int row, int col, f32x4 v) { const f32x4 k = load4(ksh + (size_t)row * RWW + col), nk = load4(nkk + (size_t)row * RWW + col); f32x4 ko, bo;
#pragma unroll
    for (int j = 0; j < 4; ++j) { const float a = sigmoidf_(a0[col + j] + v[j]); ko[j] = k[j] * (1.f + (a - 1.f) * k_a[col + j]); bo[j] = -nk[j] * a; }
    store4(KO + (size_t)row * RWW + col, ko); store4(BO + (size_t)row * RWW + col, bo); } };
struct EpiStore { bf16_t* O; int ldo;
  DI void operator()(int row, int col, f32x4 v) { store4(O + (size_t)row * ldo + col, v); } };
struct EpiMerge1 { bf16_t* O; const bf16_t* sg;
  DI void operator()(int row, int col, f32x4 v) { const f32x4 g = load4(sg + (size_t)row * SGW + col); store4(O + (size_t)row * DM + col, v * g); } };
struct EpiMerge2 { bf16_t* O; const bf16_t* sg;
  DI void operator()(int row, int col, f32x4 v) { const f32x4 g = load4(sg + (size_t)row * SGW + 1024 + col); bf16_t* o = O + (size_t)row * DM + col; const f32x4 prev = load4(o); store4(o, prev + v * g); } };

constexpr int LROW8 = 144, T8 = 256, STAGE8 = 2 * T8 * LROW8;
template <class Epi>
DI void gemm_tile8(const bf16_t* __restrict__ A, int lda, const bf16_t* __restrict__ Bt, int ldb, int K, int row0, int col0,
                   unsigned char* lds, Epi& epi) {
  const int tid = threadIdx.x, lane = tid & 63, wid = tid >> 6, wm = wid >> 2, wn = wid & 3, fr = lane & 15, fq = lane >> 4;
  f32x4 acc[8][4];
#pragma unroll
  for (int i = 0; i < 8; ++i)
#pragma unroll
    for (int j = 0; j < 4; ++j) acc[i][j] = (f32x4){0.f, 0.f, 0.f, 0.f};
  u32x4 ra[4], rb[4];
  const int lrow = tid >> 3, lkc = tid & 7;
  const bf16_t* ap = A + (size_t)(row0 + lrow) * lda + lkc * 8;
  const bf16_t* bp = Bt + (size_t)(col0 + lrow) * ldb + lkc * 8;
  const size_t astep = (size_t)64 * lda, bstep = (size_t)64 * ldb;
  unsigned char* wa = lds + lrow * LROW8 + lkc * 16;
  const int nk = K / 64, krem = K & 63;
#pragma unroll
  for (int i = 0; i < 4; ++i) ra[i] = *(const u32x4*)(ap + i * astep);
#pragma unroll
  for (int i = 0; i < 4; ++i) rb[i] = *(const u32x4*)(bp + i * bstep);
#pragma unroll
  for (int i = 0; i < 4; ++i) *(u32x4*)(wa + i * 64 * LROW8) = ra[i];
#pragma unroll
  for (int i = 0; i < 4; ++i) *(u32x4*)(wa + T8 * LROW8 + i * 64 * LROW8) = rb[i];
  __syncthreads();
  const int nkt = nk + (krem ? 1 : 0);
  for (int kt = 0; kt < nkt; ++kt) {
    const bool more = kt + 1 < nkt;
    const unsigned char* sa = lds + (kt & 1) * STAGE8 + (wm * 128 + fr) * LROW8 + fq * 16;
    const unsigned char* sb = lds + (kt & 1) * STAGE8 + T8 * LROW8 + (wn * 64 + fr) * LROW8 + fq * 16;
    const int nsub = (kt == nk) ? 1 : 2;
#pragma unroll
    for (int ks = 0; ks < 2; ++ks) {
      if (ks < nsub) {
        bf16x8 bfv[4];
#pragma unroll
        for (int j = 0; j < 4; ++j) bfv[j] = *(const bf16x8*)(sb + j * 16 * LROW8 + ks * 64);
#pragma unroll
        for (int ih = 0; ih < 2; ++ih) {
          bf16x8 af[4];
#pragma unroll
          for (int i = 0; i < 4; ++i) af[i] = *(const bf16x8*)(sa + (ih * 4 + i) * 16 * LROW8 + ks * 64);
#pragma unroll
          for (int i = 0; i < 4; ++i)
#pragma unroll
            for (int j = 0; j < 4; ++j) acc[ih * 4 + i][j] = __builtin_amdgcn_mfma_f32_16x16x32_bf16(bfv[j], af[i], acc[ih * 4 + i][j], 0, 0, 0);
          if (ks == 0) {
            asm volatile("" ::: "memory");
            if (more) {
              const int koff = (kt + 1) * 64 - ((kt + 1 == nk && krem && lkc >= 4) ? 32 : 0);
              if (ih == 0) {
#pragma unroll
                for (int i = 0; i < 4; ++i) ra[i] = *(const u32x4*)(ap + i * astep + koff);
              } else {
#pragma unroll
                for (int i = 0; i < 4; ++i) rb[i] = *(const u32x4*)(bp + i * bstep + koff);
              }
            }
            asm volatile("" ::: "memory");
          }
        }
      }
    }
    if (more) {
      unsigned char* da = wa + ((kt + 1) & 1) * STAGE8;
#pragma unroll
      for (int i = 0; i < 4; ++i) *(u32x4*)(da + i * 64 * LROW8) = ra[i];
#pragma unroll
      for (int i = 0; i < 4; ++i) *(u32x4*)(da + T8 * LROW8 + i * 64 * LROW8) = rb[i];
    }
    __syncthreads();
  }
#pragma unroll
  for (int i = 0; i < 8; ++i)
#pragma unroll
    for (int j = 0; j < 4; ++j) epi(row0 + wm * 128 + i * 16 + fr, col0 + wn * 64 + j * 16 + fq * 4, acc[i][j]);
}

DI void tile_of(int t, int ntm, int ntn, int& tm, int& tn) {
  const int G = gridDim.x;
  if ((G & 7) == 0 && (ntm & 31) == 0) {
    const int x = t & 7, l = (t >> 3), mper = ntm >> 3;
    const int gs = (mper & 7) == 0 ? 8 : 4;
    const int grp = l / (gs * ntn), r = l % (gs * ntn);
    tm = x * mper + grp * gs + (r % gs); tn = r / gs;
  } else { tm = t / ntn; tn = t % ntn; }
}
template <int MT = 0, class Epi>
DI void gemm_phase(const bf16_t* A, int lda, const bf16_t* Bt, int ldb, int K, int rows0, int nrows, int N, unsigned char* lds, Epi& epi, int rot = 0) {
  const int ntn = N / T8, ntm = nrows / T8;
  for (int t = (int)((blockIdx.x + rot) % gridDim.x); t < ntn * ntm; t += gridDim.x) {
    int tm, tn; tile_of(t, ntm, ntn, tm, tn);
    gemm_tile8(A, lda, Bt, ldb, K, rows0 + tm * T8, tn * T8, lds, epi);
  }
}

DI void phase_rwprep(const Params& p) {
  unsigned char* ws = p.ws;
  const bf16_t* z = (const bf16_t*)p.out;
  bf16_t* R = (bf16_t*)(ws + OFF_R); bf16_t* V = (bf16_t*)(ws + OFF_V); bf16_t* NKK = (bf16_t*)(ws + OFF_NKK);
  bf16_t* KSH = (bf16_t*)(ws + OFF_KSH); bf16_t* LIN = (bf16_t*)(ws + OFF_LIN);
  const float* mup = p.in[8]; const float* mun = p.in[9]; const float* k_k = p.in[15];
  const int lane = threadIdx.x & 63, gw = blockIdx.x * NWV + (threadIdx.x >> 6), nw = gridDim.x * NWV;
  constexpr int RB = 8;
  for (int rbk = gw; rbk < M_TOK / RB; rbk += nw) {
    const int row0 = rbk * RB;
    int start, T; seq_of(row0, start, T);
    const int pos0 = row0 - start;
#pragma unroll
    for (int seg = 0; seg < 4; ++seg) {
      const int c = seg < 3 ? seg * 512 + lane * 8 : 1536 + lane * 8;
      if (seg == 3 && lane >= 52) break;
      float mp[8], mn[8], kkw[8];
#pragma unroll
      for (int e = 0; e < 8; ++e) { mp[e] = mup[c + e]; mn[e] = mun[c + e]; kkw[e] = seg == 1 ? k_k[lane * 8 + e] : 0.f; }
      const bf16_t* zr = z + (size_t)row0 * ZLD + c;
      float zp[8], zc[8], zn[8], zs[8];
      if (pos0 > 0) unpack8(*(const u32x4*)(zr - ZLD), zp); else { for (int e = 0; e < 8; ++e) zp[e] = 0.f; }
      unpack8(*(const u32x4*)zr, zc);
#pragma unroll
      for (int r = 0; r < RB; ++r) {
        const int row = row0 + r;
        if (pos0 + r < T - 1) unpack8(*(const u32x4*)(zr + (size_t)(r + 1) * ZLD), zn); else { for (int e = 0; e < 8; ++e) zn[e] = 0.f; }
#pragma unroll
        for (int e = 0; e < 8; ++e) zs[e] = zc[e] + mp[e] * (zp[e] - zc[e]) + mn[e] * (zn[e] - zc[e]);
        if (seg == 0) *(u32x4*)(R + (size_t)row * RWW + lane * 8) = pack8(zs);
        else if (seg == 2) *(u32x4*)(V + (size_t)row * RWW + lane * 8) = pack8(zs);
        else if (seg == 1) {
          *(u32x4*)(KSH + (size_t)row * RWW + lane * 8) = pack8(zs);
          float kk[8], ss = 0.f;
#pragma unroll
          for (int e = 0; e < 8; ++e) { kk[e] = zs[e] * kkw[e]; ss += kk[e] * kk[e]; }
          ss += __shfl_xor(ss, 1); ss += __shfl_xor(ss, 2); ss += __shfl_xor(ss, 4);
          const float inv = -1.f / fmaxf(sqrtf(ss), 1e-12f);
#pragma unroll
          for (int e = 0; e < 8; ++e) kk[e] *= inv;
          *(u32x4*)(NKK + (size_t)row * RWW + lane * 8) = pack8(kk);
        } else {
#pragma unroll
          for (int e = 0; e < 8; ++e) {
            if (lane < 16) { const float t2 = __expf(2.f * zs[e]); zs[e] = 1.f - 2.f / (t2 + 1.f); }
            else if (lane >= 32) zs[e] = sigmoidf_(zs[e]);
          }
          *(u32x4*)(LIN + (size_t)row * LINW + lane * 8) = pack8(zs);
        }
#pragma unroll
        for (int e = 0; e < 8; ++e) { zp[e] = zc[e]; zc[e] = zn[e]; }
      }
    }
  }
}

DI float dpp_xor1(float v) { return __builtin_bit_cast(float, __builtin_amdgcn_update_dpp(0, __builtin_bit_cast(int, v), 0xB1, 0xF, 0xF, false)); }
DI float dpp_xor2(float v) { return __builtin_bit_cast(float, __builtin_amdgcn_update_dpp(0, __builtin_bit_cast(int, v), 0x4E, 0xF, 0xF, false)); }
struct ScanRaw { u32x4 r[2], w[2], k[2], a[2], b[2]; u32x2 v; };
DI void unpack16_2(const u32x4* u, f32x2* f) {
#pragma unroll
  for (int i = 0; i < 2; ++i) { f[i * 4 + 0] = (f32x2){lo2f(u[i].x), hi2f(u[i].x)}; f[i * 4 + 1] = (f32x2){lo2f(u[i].y), hi2f(u[i].y)};
    f[i * 4 + 2] = (f32x2){lo2f(u[i].z), hi2f(u[i].z)}; f[i * 4 + 3] = (f32x2){lo2f(u[i].w), hi2f(u[i].w)}; }
}
constexpr int NCH = 8, CHL = T_P / NCH;
constexpr size_t OFF_QB = 979 * MBY  , OFF_ST = 1011 * MBY  ;
constexpr int SCAN_TS = 8, SCAN_WLDS = SCAN_TS * 6 * 64 * 4;
DI void phase_scan(const Params& p, unsigned char* ldsb) {
  unsigned char* ws = p.ws;
  const bf16_t* R = (const bf16_t*)(ws + OFF_R); const bf16_t* V = (const bf16_t*)(ws + OFF_V); const bf16_t* NKK = (const bf16_t*)(ws + OFF_NKK);
  const int wid = threadIdx.x >> 6, lane = threadIdx.x & 63, rg = lane >> 2, cgp = lane & 3;
  float* L = (float*)(ldsb + wid * SCAN_WLDS);
  const int sst = lane >> 3, sch = lane & 7;
  constexpr int NCHAIN = 32 * 16 + NCH * 16 * 2;
  for (int chain = blockIdx.x * 3 + wid; wid < 3 && chain < NCHAIN; chain += 3 * gridDim.x) {
    int hd, start, T, i0, mode, cidx = 0;
    if (chain < 512) { hd = chain & 15; start = T_P + (chain >> 4) * T_S; T = T_S; i0 = 0; mode = 0; }
    else { const int pc = chain - 512; mode = pc & 1; hd = (pc >> 1) & 15; cidx = pc >> 5; start = 0; T = T_P; i0 = cidx * CHL; }
    const int h = hd >> 1, d = hd & 1;
    const bf16_t* Wd = (const bf16_t*)((const unsigned char*)p.out + (size_t)d * SEG);
    const bf16_t* Kd = (const bf16_t*)((const unsigned char*)p.out + (size_t)(2 + d) * SEG);
    const bf16_t* Bd = (const bf16_t*)(ws + OFF_BF + (size_t)d * SEG);
    bf16_t* YS = mode ? (bf16_t*)(ws + OFF_QB + (size_t)d * T_P * RWW * 2) : (bf16_t*)(ws + OFF_YS + (size_t)d * SEG);
    const int rb = h * 64 + rg * 4;
    f32x2 S[4][8];
#pragma unroll
    for (int r = 0; r < 4; ++r)
#pragma unroll
      for (int c = 0; c < 8; ++c) {
        const int row = rg * 4 + r, col = cgp * 16 + 2 * c;
        S[r][c] = (f32x2){(mode && row == col) ? 1.f : 0.f, (mode && row == col + 1) ? 1.f : 0.f};
      }
    u32x4 g[6];
    auto gload = [&](int ic) {
      const int i = ic + sst, t = d ? T - 1 - i : i; const size_t o = (size_t)(start + t) * RWW + h * 64 + sch * 8;
      g[0] = *(const u32x4*)(NKK + o); g[1] = *(const u32x4*)(Wd + o); g[2] = *(const u32x4*)(Bd + o);
      g[3] = *(const u32x4*)(Kd + o); g[4] = *(const u32x4*)(R + o); g[5] = *(const u32x4*)(V + o);
    };
    auto lwrite = [&]() {
#pragma unroll
      for (int x = 0; x < 6; ++x) {
        float f[8]; unpack8(g[x], f);
        if (x == 1) { for (int e = 0; e < 8; ++e) f[e] = 1.f - f[e]; }
        if (x == 5 && mode) { for (int e = 0; e < 8; ++e) f[e] = 0.f; }
        float* dst = L + sst * 384 + x * 64 + sch * 8;
        *(f32x4*)dst = (f32x4){f[0], f[1], f[2], f[3]}; *(f32x4*)(dst + 4) = (f32x4){f[4], f[5], f[6], f[7]};
      }
    };
    gload(i0); lwrite();
    const int iend = i0 + T_S;
#pragma unroll 1
    for (int ic = i0; ic < iend; ic += SCAN_TS) {
      const bool more = ic + SCAN_TS < iend;
      if (more) gload(ic + SCAN_TS);
#pragma unroll
      for (int s = 0; s < SCAN_TS; ++s) {
        const float* Ls = L + s * 384;
        const f32x4 vq = *(const f32x4*)(Ls + 5 * 64 + rg * 4);
        const float vv[4] = {vq.x, vq.y, vq.z, vq.w};
        f32x2 sa2[4], y2[4];
        {
          f32x2 aa[8];
#pragma unroll
          for (int q = 0; q < 4; ++q) { const f32x4 t4 = *(const f32x4*)(Ls + 0 * 64 + cgp * 16 + q * 4); aa[2 * q] = (f32x2){t4.x, t4.y}; aa[2 * q + 1] = (f32x2){t4.z, t4.w}; }
#pragma unroll
          for (int r = 0; r < 4; ++r) {
            f32x2 s2 = S[r][0] * aa[0];
#pragma unroll
            for (int c = 1; c < 8; ++c) s2 += S[r][c] * aa[c];
            float sa = s2.x + s2.y;
            sa += dpp_xor1(sa); sa += dpp_xor2(sa);
            sa2[r] = (f32x2){sa, sa}; y2[r] = (f32x2){0.f, 0.f};
          }
        }
#pragma unroll
        for (int q = 0; q < 4; ++q) {
          const f32x4 w4 = *(const f32x4*)(Ls + 1 * 64 + cgp * 16 + q * 4), b4 = *(const f32x4*)(Ls + 2 * 64 + cgp * 16 + q * 4);
          const f32x4 k4 = *(const f32x4*)(Ls + 3 * 64 + cgp * 16 + q * 4), r4 = *(const f32x4*)(Ls + 4 * 64 + cgp * 16 + q * 4);
#pragma unroll
          for (int hh = 0; hh < 2; ++hh) {
            const int c = 2 * q + hh;
            const f32x2 w = hh ? (f32x2){w4.z, w4.w} : (f32x2){w4.x, w4.y}, b = hh ? (f32x2){b4.z, b4.w} : (f32x2){b4.x, b4.y};
            const f32x2 k = hh ? (f32x2){k4.z, k4.w} : (f32x2){k4.x, k4.y}, rr = hh ? (f32x2){r4.z, r4.w} : (f32x2){r4.x, r4.y};
#pragma unroll
            for (int r = 0; r < 4; ++r) {
              const f32x2 v2 = {vv[r], vv[r]};
              S[r][c] = S[r][c] * w + (sa2[r] * b + v2 * k);
              y2[r] += S[r][c] * rr;
            }
          }
        }
        float y[4];
#pragma unroll
        for (int r = 0; r < 4; ++r) { float yy = y2[r].x + y2[r].y; yy += dpp_xor1(yy); yy += dpp_xor2(yy); y[r] = yy; }
        if (cgp == 0) {
          const int i = ic + s, t = d ? T - 1 - i : i;
          u32x2 o; o.x = pk2(y[0], y[1]); o.y = pk2(y[2], y[3]);
          *(u32x2*)(YS + (size_t)(start + t) * RWW + rb) = o;
        }
      }
      if (more) lwrite();
    }
    if (chain >= 512) {
      float* st = (float*)(ws + OFF_ST) + ((size_t)(cidx * 16 + hd) * 2 + mode) * 4096;
#pragma unroll
      for (int r = 0; r < 4; ++r)
#pragma unroll
        for (int c = 0; c < 8; ++c) *(f32x2*)(st + (rg * 4 + r) * 64 + cgp * 16 + 2 * c) = S[r][c];
    }
  }
}

DI void phase_scan_fix(const Params& p, unsigned char* ldsb) {
  unsigned char* ws = p.ws;
  const int tid = threadIdx.x, lane = tid & 63, wid = tid >> 6;
  constexpr int NSUB = 2, SUBL = CHL / NSUB;
  float* SA = (float*)ldsb; float* SB = SA + 64 * 65;
  for (int item = blockIdx.x; item < (NCH - 1) * 16 * NSUB; item += gridDim.x) {
    const int c = 1 + item / (16 * NSUB), rem = item % (16 * NSUB), hd = rem / NSUB, sub = rem % NSUB, h = hd >> 1, d = hd & 1;
    const int fi = (tid & 255) >> 2, fj = (tid & 3) * 16;
    float* cur = SA; float* nxt = SB;
    __syncthreads();
    {
      const float* U0 = (const float*)(ws + OFF_ST) + ((size_t)(0 * 16 + hd) * 2 + 0) * 4096;
      if (tid < 256) {
#pragma unroll
        for (int k = 0; k < 16; ++k) cur[fi * 65 + fj + k] = U0[fi * 64 + fj + k];
      }
    }
    __syncthreads();
#pragma unroll 1
    for (int cc = 1; cc < c; ++cc) {
      const float* U = (const float*)(ws + OFF_ST) + ((size_t)(cc * 16 + hd) * 2 + 0) * 4096;
      const float* P = U + 4096;
      if (tid < 256) {
      f32x4 acc[4];
#pragma unroll
      for (int j = 0; j < 4; ++j) acc[j] = *(const f32x4*)(U + fi * 64 + fj + j * 4);
#pragma unroll 4
      for (int m = 0; m < 64; ++m) {
        const float s = cur[fi * 65 + m];
#pragma unroll
        for (int j = 0; j < 4; ++j) acc[j] += *(const f32x4*)(P + m * 64 + fj + j * 4) * s;
      }
#pragma unroll
      for (int j = 0; j < 4; ++j) { nxt[fi * 65 + fj + j * 4] = acc[j].x; nxt[fi * 65 + fj + j * 4 + 1] = acc[j].y; nxt[fi * 65 + fj + j * 4 + 2] = acc[j].z; nxt[fi * 65 + fj + j * 4 + 3] = acc[j].w; }
      }
      __syncthreads();
      float* t2 = cur; cur = nxt; nxt = t2;
    }
    float S[64];
#pragma unroll
    for (int j = 0; j < 64; ++j) S[j] = cur[lane * 65 + j];
    const bf16_t* QB = (const bf16_t*)(ws + OFF_QB + (size_t)d * T_P * RWW * 2);
    bf16_t* YS = (bf16_t*)(ws + OFF_YS + (size_t)d * SEG);
#pragma unroll 1
    for (int i = c * CHL + sub * SUBL + wid; i < c * CHL + (sub + 1) * SUBL; i += NWV) {
      const int t = d ? T_P - 1 - i : i; const size_t o = (size_t)t * RWW + h * 64;
      float corr = 0.f;
#pragma unroll
      for (int c8 = 0; c8 < 8; ++c8) { float q[8]; unpack8(*(const u32x4*)(QB + o + c8 * 8), q);
#pragma unroll
        for (int e = 0; e < 8; ++e) corr += S[c8 * 8 + e] * q[e]; }
      const float y = bf2f(YS[o + lane]) + corr;
      YS[o + lane] = (bf16_t)(pk2(y, 0.f) & 0xffffu);
    }
  }
}

DI void phase_rwfinish(const Params& p) {
  unsigned char* ws = p.ws;
  const bf16_t* YF = (const bf16_t*)(ws + OFF_YS); const bf16_t* YB = (const bf16_t*)(ws + OFF_YS + SEG);
  const bf16_t* R = (const bf16_t*)(ws + OFF_R); const bf16_t* V = (const bf16_t*)(ws + OFF_V); const bf16_t* G = (const bf16_t*)(ws + OFF_G);
  const bf16_t* KF = (const bf16_t*)((const unsigned char*)p.out + 2 * SEG); const bf16_t* KB = (const bf16_t*)((const unsigned char*)p.out + 3 * SEG);
  bf16_t* O = (bf16_t*)p.out;
  const float* r_k = p.in[17]; const float* ln_w = p.in[18]; const float* ln_b = p.in[19];
  const int lane = threadIdx.x & 63, gw = blockIdx.x * NWV + (threadIdx.x >> 6), nw = gridDim.x * NWV;
  for (int it = gw; it < M_TOK * 2; it += nw) {
    const int row = it >> 1, ch = (it & 1) * 256 + lane * 4;
    const size_t o = (size_t)row * RWW + ch;
    const f32x4 yf = load4(YF + o), yb = load4(YB + o), r = load4(R + o), kf = load4(KF + o), kb = load4(KB + o), v = load4(V + o), g = load4(G + o);
    const f32x4 y = yf + yb;
    const f32x4 rk = *(const f32x4*)(r_k + ch);
    float s = y.x + y.y + y.z + y.w;
    const f32x4 bq = r * (kf + kb) * rk;
    float bs = bq.x + bq.y + bq.z + bq.w;
#pragma unroll
    for (int m = 1; m < 16; m <<= 1) { s += __shfl_xor(s, m); bs += __shfl_xor(bs, m); }
    const float mu = s * (1.f / 64.f);
    const f32x4 dv = y - mu;
    float q = dv.x * dv.x + dv.y * dv.y + dv.z * dv.z + dv.w * dv.w;
#pragma unroll
    for (int m = 1; m < 16; m <<= 1) q += __shfl_xor(q, m);
    const float rs = rsqrtf(q * (1.f / 64.f) + 64e-5f);
    const f32x4 lw = *(const f32x4*)(ln_w + ch), lb = *(const f32x4*)(ln_b + ch);
    const f32x4 res = (dv * rs * lw + lb + v * bs) * g;
    store4(O + o, res);
  }
}

DI void phase_attn(const Params& p, unsigned char* lds) {
  unsigned char* ws = p.ws;
  const bf16_t* qkv = (const bf16_t*)(ws + OFF_QKV);
  bf16_t* oatt = (bf16_t*)(ws + OFF_QKV);
  const int tid = threadIdx.x, lane = tid & 63, wid = tid >> 6, fr = lane & 15, fq = lane >> 4;
  const int kvh = wid >> 2;
  bf16_t* KsAll = (bf16_t*)lds; bf16_t* VtAll = (bf16_t*)(lds + 9216);
  const bf16_t* Ks = KsAll + kvh * (32 * 72);
  const bf16_t* Vt = VtAll + kvh * (64 * 36);
  const int njobs = M_TOK / 32;
  for (int job = blockIdx.x; job < njobs; job += gridDim.x) {
    const int q0 = job * 32;
    int start, T; seq_of(q0, start, T);
    const int h = wid;
    const float slope = exp2f(-(float)(h + 1)), sink = p.in[7][h];
    bf16x8 qf[2][2];
#pragma unroll
    for (int mt = 0; mt < 2; ++mt)
#pragma unroll
      for (int ks = 0; ks < 2; ++ks) qf[mt][ks] = *(const bf16x8*)(qkv + (size_t)(q0 + mt * 16 + fr) * QKVW + h * 64 + ks * 32 + fq * 8);
    f32x4 o[4][2];
#pragma unroll
    for (int a = 0; a < 4; ++a)
#pragma unroll
      for (int b = 0; b < 2; ++b) o[a][b] = (f32x4){0.f, 0.f, 0.f, 0.f};
    float mrun[2], lrun[2];
#pragma unroll
    for (int mt = 0; mt < 2; ++mt) { mrun[mt] = sink; lrun[mt] = fq == 0 ? 1.f : 0.f; }
#pragma unroll 1
    for (int kt = 0; kt < 9; ++kt) {
      const int kb = q0 - 128 + kt * 32, kbr = kb - start;
      if (kbr < 128 || kbr >= T + 128) continue;
      const bool phantom = kbr >= T;
      __syncthreads();
      {
        const int skv = tid >> 8, key = (tid & 255) >> 3, dc = tid & 7;
        const bf16_t* src = qkv + (size_t)(kb + key) * QKVW + 512 + skv * 64 + dc * 8;
        u32x4 kvv = {0u, 0u, 0u, 0u}, vv = {0u, 0u, 0u, 0u};
        if (!phantom) { kvv = *(const u32x4*)src; vv = *(const u32x4*)(src + 128); }
        bf16_t* Vw = VtAll + skv * (64 * 36);
        *(u32x4*)(KsAll + skv * (32 * 72) + key * 72 + dc * 8) = kvv;
        const unsigned w[4] = {vv.x, vv.y, vv.z, vv.w};
#pragma unroll
        for (int e = 0; e < 4; ++e) { Vw[(dc * 8 + 2 * e) * 36 + key] = (bf16_t)(w[e] & 0xffffu); Vw[(dc * 8 + 2 * e + 1) * 36 + key] = (bf16_t)(w[e] >> 16); }
      }
      __syncthreads();
#pragma unroll
      for (int mt = 0; mt < 2; ++mt) {
        f32x4 s[2];
#pragma unroll
        for (int nt = 0; nt < 2; ++nt) {
          s[nt] = (f32x4){0.f, 0.f, 0.f, 0.f};
#pragma unroll
          for (int ks = 0; ks < 2; ++ks) {
            const bf16x8 kf = *(const bf16x8*)(Ks + (nt * 16 + fr) * 72 + ks * 32 + fq * 8);
            s[nt] = __builtin_amdgcn_mfma_f32_16x16x32_bf16(kf, qf[mt][ks], s[nt], 0, 0, 0);
          }
        }
        const int tq = q0 + mt * 16 + fr;
        float mx = -1e30f;
#pragma unroll
        for (int nt = 0; nt < 2; ++nt)
#pragma unroll
          for (int j = 0; j < 4; ++j) {
            const int tk = kb + nt * 16 + fq * 4 + j; const int dist = tq > tk ? tq - tk : tk - tq;
            const float sc = dist <= 128 ? s[nt][j] * 0.125f - slope * (float)dist : -1e30f;
            s[nt][j] = sc; mx = fmaxf(mx, sc);
          }
        mx = fmaxf(mx, __shfl_xor(mx, 16)); mx = fmaxf(mx, __shfl_xor(mx, 32));
        const float mnew = fmaxf(mrun[mt], mx), alpha = __expf(mrun[mt] - mnew);
        mrun[mt] = mnew;
        float ls = 0.f;
#pragma unroll
        for (int nt = 0; nt < 2; ++nt)
#pragma unroll
          for (int j = 0; j < 4; ++j) { const float pe = __expf(s[nt][j] - mnew); s[nt][j] = pe; ls += pe; }
        lrun[mt] = lrun[mt] * alpha + ls;
#pragma unroll
        for (int dt = 0; dt < 4; ++dt) o[dt][mt] = o[dt][mt] * alpha;
        u32x4 pu; pu.x = pk2(s[0][0], s[0][1]); pu.y = pk2(s[0][2], s[0][3]); pu.z = pk2(s[1][0], s[1][1]); pu.w = pk2(s[1][2], s[1][3]);
        const bf16x8 pf = __builtin_bit_cast(bf16x8, pu);
#pragma unroll
        for (int dt = 0; dt < 4; ++dt) {
          const bf16_t* vrow = Vt + (dt * 16 + fr) * 36 + fq * 4;
          u32x4 vu; const u32x2 v0 = *(const u32x2*)(vrow), v1 = *(const u32x2*)(vrow + 16);
          vu.x = v0.x; vu.y = v0.y; vu.z = v1.x; vu.w = v1.y;
          o[dt][mt] = __builtin_amdgcn_mfma_f32_16x16x32_bf16(__builtin_bit_cast(bf16x8, vu), pf, o[dt][mt], 0, 0, 0);
        }
      }
    }
#pragma unroll
    for (int mt = 0; mt < 2; ++mt) {
      float l = lrun[mt]; l += __shfl_xor(l, 16); l += __shfl_xor(l, 32);
      const float inv = 1.f / l;
#pragma unroll
      for (int dt = 0; dt < 4; ++dt) store4(oatt + (size_t)(q0 + mt * 16 + fr) * QKVW + h * 64 + dt * 16 + fq * 4, o[dt][mt] * inv);
    }
  }
}


DI void phase_attn_wave(const Params& p, unsigned char* ldsw, int first, int stride) {
  unsigned char* ws = p.ws;
  const bf16_t* qkv = (const bf16_t*)(ws + OFF_QKV);
  bf16_t* oatt = (bf16_t*)(ws + OFF_QKV);
  const int lane = threadIdx.x & 63, fr = lane & 15, fq = lane >> 4;
  bf16_t* Ks = (bf16_t*)ldsw;
  bf16_t* Vt = (bf16_t*)(ldsw + 4608);
  const int njobs = (M_TOK / 32) * 8;
  for (int job = first; job < njobs; job += stride) {
    const int q0 = (job >> 3) * 32, h = job & 7, kvh = h >> 2;
    int start, T; seq_of(q0, start, T);
    const float slope = exp2f(-(float)(h + 1)), sink = p.in[7][h];
    bf16x8 qf[2][2];
#pragma unroll
    for (int mt = 0; mt < 2; ++mt)
#pragma unroll
      for (int ks = 0; ks < 2; ++ks) qf[mt][ks] = *(const bf16x8*)(qkv + (size_t)(q0 + mt * 16 + fr) * QKVW + h * 64 + ks * 32 + fq * 8);
    f32x4 o[4][2];
#pragma unroll
    for (int a = 0; a < 4; ++a)
#pragma unroll
      for (int b = 0; b < 2; ++b) o[a][b] = (f32x4){0.f, 0.f, 0.f, 0.f};
    float mrun[2], lrun[2];
#pragma unroll
    for (int mt = 0; mt < 2; ++mt) { mrun[mt] = sink; lrun[mt] = fq == 0 ? 1.f : 0.f; }
#pragma unroll 1
    for (int kt = 0; kt < 9; ++kt) {
      const int kb = q0 - 128 + kt * 32, kbr = kb - start;
      if (kbr < 128 || kbr >= T + 128) continue;
      const bool phantom = kbr >= T;
      asm volatile("" ::: "memory");
#pragma unroll
      for (int i = 0; i < 4; ++i) {
        const int c = lane + 64 * i, key = c >> 3, dc = c & 7;
        const bf16_t* src = qkv + (size_t)(kb + key) * QKVW + 512 + kvh * 64 + dc * 8;
        u32x4 kvv = {0u, 0u, 0u, 0u}, vv = {0u, 0u, 0u, 0u};
        if (!phantom) { kvv = *(const u32x4*)src; vv = *(const u32x4*)(src + 128); }
        *(u32x4*)(Ks + key * 72 + dc * 8) = kvv;
        const unsigned w[4] = {vv.x, vv.y, vv.z, vv.w};
#pragma unroll
        for (int e = 0; e < 4; ++e) { Vt[(dc * 8 + 2 * e) * 36 + key] = (bf16_t)(w[e] & 0xffffu); Vt[(dc * 8 + 2 * e + 1) * 36 + key] = (bf16_t)(w[e] >> 16); }
      }
      asm volatile("s_waitcnt lgkmcnt(0)" ::: "memory");
#pragma unroll
      for (int mt = 0; mt < 2; ++mt) {
        f32x4 s[2];
#pragma unroll
        for (int nt = 0; nt < 2; ++nt) {
          s[nt] = (f32x4){0.f, 0.f, 0.f, 0.f};
#pragma unroll
          for (int ks = 0; ks < 2; ++ks) {
            const bf16x8 kf = *(const bf16x8*)(Ks + (nt * 16 + fr) * 72 + ks * 32 + fq * 8);
            s[nt] = __builtin_amdgcn_mfma_f32_16x16x32_bf16(kf, qf[mt][ks], s[nt], 0, 0, 0);
          }
        }
        const int tq = q0 + mt * 16 + fr;
        float mx = -1e30f;
#pragma unroll
        for (int nt = 0; nt < 2; ++nt)
#pragma unroll
          for (int j = 0; j < 4; ++j) {
            const int tk = kb + nt * 16 + fq * 4 + j; const int dist = tq > tk ? tq - tk : tk - tq;
            const float sc = dist <= 128 ? s[nt][j] * 0.125f - slope * (float)dist : -1e30f;
            s[nt][j] = sc; mx = fmaxf(mx, sc);
          }
        mx = fmaxf(mx, __shfl_xor(mx, 16)); mx = fmaxf(mx, __shfl_xor(mx, 32));
        const float mnew = fmaxf(mrun[mt], mx), alpha = __expf(mrun[mt] - mnew);
        mrun[mt] = mnew;
        float ls = 0.f;
#pragma unroll
        for (int nt = 0; nt < 2; ++nt)
#pragma unroll
          for (int j = 0; j < 4; ++j) { const float pe = __expf(s[nt][j] - mnew); s[nt][j] = pe; ls += pe; }
        lrun[mt] = lrun[mt] * alpha + ls;
#pragma unroll
        for (int dt = 0; dt < 4; ++dt) o[dt][mt] = o[dt][mt] * alpha;
        u32x4 pu; pu.x = pk2(s[0][0], s[0][1]); pu.y = pk2(s[0][2], s[0][3]); pu.z = pk2(s[1][0], s[1][1]); pu.w = pk2(s[1][2], s[1][3]);
        const bf16x8 pf = __builtin_bit_cast(bf16x8, pu);
#pragma unroll
        for (int dt = 0; dt < 4; ++dt) {
          const bf16_t* vrow = Vt + (dt * 16 + fr) * 36 + fq * 4;
          u32x4 vu; const u32x2 v0 = *(const u32x2*)(vrow), v1 = *(const u32x2*)(vrow + 16);
          vu.x = v0.x; vu.y = v0.y; vu.z = v1.x; vu.w = v1.y;
          o[dt][mt] = __builtin_amdgcn_mfma_f32_16x16x32_bf16(__builtin_bit_cast(bf16x8, vu), pf, o[dt][mt], 0, 0, 0);
        }
      }
    }
#pragma unroll
    for (int mt = 0; mt < 2; ++mt) {
      float l = lrun[mt]; l += __shfl_xor(l, 16); l += __shfl_xor(l, 32);
      const float inv = 1.f / l;
#pragma unroll
      for (int dt = 0; dt < 4; ++dt) store4(oatt + (size_t)(q0 + mt * 16 + fr) * QKVW + h * 64 + dt * 16 + fq * 4, o[dt][mt] * inv);
    }
  }
}

#ifndef NAIVE_ATTN
#define NAIVE_ATTN 0
#endif
#ifndef NAIVE_SCAN
#define NAIVE_SCAN 0
#endif
DI void phase_attn_naive(const Params& p) {
  unsigned char* ws = p.ws;
  const bf16_t* qkv = (const bf16_t*)(ws + OFF_QKV);
  bf16_t* oatt = (bf16_t*)(ws + OFF_QKV);
  const int lane = threadIdx.x & 63, gw = blockIdx.x * NWV + (threadIdx.x >> 6), nw = gridDim.x * NWV;
  for (int item = gw; item < M_TOK * 8; item += nw) {
    const int row = item >> 3, h = item & 7, kvh = h >> 2;
    int start, T; seq_of(row, start, T);
    const float slope = exp2f(-(float)(h + 1)), sink = p.in[7][h];
    const float q = bf2f(qkv[(size_t)row * QKVW + h * 64 + lane]);
    const int lo = max(row - 128, start + 128), hi = min(row + 128, start + T + 127);
    float m = sink, l = 1.f, acc = 0.f;
    for (int s = lo; s <= hi; ++s) {
      const bool real = s < start + T;
      const float kx = real ? bf2f(qkv[(size_t)s * QKVW + 512 + kvh * 64 + lane]) : 0.f;
      const float vx = real ? bf2f(qkv[(size_t)s * QKVW + 640 + kvh * 64 + lane]) : 0.f;
      const int dist = row > s ? row - s : s - row;
      const float sc = wave_sum(q * kx) * 0.125f - slope * (float)dist;
      const float mnew = fmaxf(m, sc), alpha = __expf(m - mnew), pe = __expf(sc - mnew);
      l = l * alpha + pe; acc = acc * alpha + pe * vx; m = mnew;
    }
    oatt[(size_t)row * QKVW + h * 64 + lane] = (bf16_t)(pk2(acc / l, 0.f) & 0xffffu);
  }
}
DI void phase_scan_naive(const Params& p) {
  unsigned char* ws = p.ws;
  const bf16_t* R = (const bf16_t*)(ws + OFF_R); const bf16_t* V = (const bf16_t*)(ws + OFF_V); const bf16_t* NKK = (const bf16_t*)(ws + OFF_NKK);
  const int wid = threadIdx.x >> 6, lane = threadIdx.x & 63;
  for (int chain = wid * gridDim.x + blockIdx.x; chain < 33 * 16; chain += 4 * gridDim.x) {
    const int seq = chain >> 4, hd = chain & 15, h = hd >> 1, d = hd & 1;
    const int start = seq == 0 ? 0 : T_P + (seq - 1) * T_S, T = seq == 0 ? T_P : T_S;
    const bf16_t* Wd = (const bf16_t*)((const unsigned char*)p.out + (size_t)d * SEG);
    const bf16_t* Kd = (const bf16_t*)((const unsigned char*)p.out + (size_t)(2 + d) * SEG);
    const bf16_t* Bd = (const bf16_t*)(ws + OFF_BF + (size_t)d * SEG);
    bf16_t* YS = (bf16_t*)(ws + OFF_YS + (size_t)d * SEG);
    float S[64];
#pragma unroll
    for (int j = 0; j < 64; ++j) S[j] = 0.f;
    for (int i = 0; i < T; ++i) {
      const int t = d ? T - 1 - i : i; const size_t o = (size_t)(start + t) * RWW + h * 64;
      const float v = bf2f(V[o + lane]);
      float sa = 0.f;
#pragma unroll
      for (int c = 0; c < 8; ++c) { float a[8]; unpack8(*(const u32x4*)(NKK + o + c * 8), a);
#pragma unroll
        for (int e = 0; e < 8; ++e) sa += S[c * 8 + e] * a[e]; }
      float y = 0.f;
#pragma unroll
      for (int c = 0; c < 8; ++c) { float w[8], k[8], b[8], r[8];
        unpack8(*(const u32x4*)(Wd + o + c * 8), w); unpack8(*(const u32x4*)(Kd + o + c * 8), k); unpack8(*(const u32x4*)(Bd + o + c * 8), b); unpack8(*(const u32x4*)(R + o + c * 8), r);
#pragma unroll
        for (int e = 0; e < 8; ++e) { const float sn = S[c * 8 + e] * (1.f - w[e]) + sa * b[e] + v * k[e]; S[c * 8 + e] = sn; y += sn * r[e]; } }
      YS[o + lane] = (bf16_t)(pk2(y, 0.f) & 0xffffu);
    }
  }
}
DI void phase_row_h(const Params& p) {
  unsigned char* ws = p.ws;
  const bf16_t* MO = (const bf16_t*)(ws + OFF_MO); bf16_t* HB = (bf16_t*)(ws + OFF_HB); float* rstdh = (float*)(ws + OFF_RSTDH);
  const float* g = p.in[3];
  const int lane = threadIdx.x & 63, gw = blockIdx.x * NWV + (threadIdx.x >> 6), nw = gridDim.x * NWV;
  for (int row = gw; row < M_TOK; row += nw) {
    const float* xs = row < T_P ? p.in[0] + (size_t)row * DM : p.in[1] + (size_t)(row - T_P) * DM;
    float m[16]; float ss = 0.f;
#pragma unroll
    for (int i = 0; i < 2; ++i) unpack8(*(const u32x4*)(MO + (size_t)row * DM + i * 512 + lane * 8), m + i * 8);
#pragma unroll
    for (int e = 0; e < 16; ++e) ss += m[e] * m[e];
    ss = wave_sum(ss);
    const float rs = rsqrtf(ss * (1.f / DM) + 1e-6f);
    float hs = 0.f; float hv[16];
#pragma unroll
    for (int i = 0; i < 2; ++i)
#pragma unroll
      for (int q = 0; q < 2; ++q) {
        const int c = i * 512 + lane * 8 + q * 4;
        const f32x4 xv = *(const f32x4*)(xs + c), gv = *(const f32x4*)(g + c);
        f32x4 hh;
#pragma unroll
        for (int e = 0; e < 4; ++e) { hh[e] = xv[e] + m[i * 8 + q * 4 + e] * rs * gv[e]; hv[i * 8 + q * 4 + e] = hh[e]; hs += hh[e] * hh[e]; }
        *(f32x4*)(p.out + (size_t)row * DM + c) = hh;
      }
#pragma unroll
    for (int i = 0; i < 2; ++i) *(u32x4*)(HB + (size_t)row * DM + i * 512 + lane * 8) = pack8(hv + i * 8);
    hs = wave_sum(hs);
    if (lane == 0) rstdh[row] = rsqrtf(hs * (1.f / DM) + 1e-6f);
  }
}
DI void phase_row_out(const Params& p) {
  unsigned char* ws = p.ws;
  const bf16_t* F = (const bf16_t*)(ws + OFF_F);
  const float* g = p.in[5];
  const int lane = threadIdx.x & 63, gw = blockIdx.x * NWV + (threadIdx.x >> 6), nw = gridDim.x * NWV;
  for (int row = gw; row < M_TOK; row += nw) {
    float m[16]; float ss = 0.f;
#pragma unroll
    for (int i = 0; i < 2; ++i) unpack8(*(const u32x4*)(F + (size_t)row * DM + i * 512 + lane * 8), m + i * 8);
#pragma unroll
    for (int e = 0; e < 16; ++e) ss += m[e] * m[e];
    ss = wave_sum(ss);
    const float rs = rsqrtf(ss * (1.f / DM) + 1e-6f);
#pragma unroll
    for (int i = 0; i < 2; ++i)
#pragma unroll
      for (int q = 0; q < 2; ++q) {
        const int c = i * 512 + lane * 8 + q * 4;
        float* op = p.out + (size_t)row * DM + c;
        const f32x4 hv = *(const f32x4*)op, gv = *(const f32x4*)(g + c);
        f32x4 r;
#pragma unroll
        for (int e = 0; e < 4; ++e) r[e] = hv[e] + m[i * 8 + q * 4 + e] * rs * gv[e];
        *(f32x4*)op = r;
      }
  }
}
DI void phase_convglu(const Params& p, int hf) {
  unsigned char* ws = p.ws;
  const bf16_t* HUP = (const bf16_t*)(ws + OFF_HUP); bf16_t* ACT = (bf16_t*)(ws + (hf ? OFF_ACT1 : OFF_ACT));
  const float* cw = p.in[24]; const float* cbias = p.in[25];
  constexpr int RB = 16, NCHK = DFF / 8;
  const int total = (HALF_ROWS / RB) * NCHK;
  for (int idx = blockIdx.x * NTHR + threadIdx.x; idx < total; idx += gridDim.x * NTHR) {
    const int rbk = idx / NCHK, c = (idx % NCHK) * 8, lr0 = rbk * RB, row0 = hf * HALF_ROWS + lr0;
    int start, T; seq_of(row0, start, T);
    const int pos0 = row0 - start;
    float w[2][3][8], bs[2][8];
#pragma unroll
    for (int part = 0; part < 2; ++part) {
#pragma unroll
      for (int d = 0; d < 3; ++d) {
        const f32x4 a = *(const f32x4*)(cw + d * 2 * DFF + part * DFF + c), b = *(const f32x4*)(cw + d * 2 * DFF + part * DFF + c + 4);
        w[part][d][0] = a.x; w[part][d][1] = a.y; w[part][d][2] = a.z; w[part][d][3] = a.w; w[part][d][4] = b.x; w[part][d][5] = b.y; w[part][d][6] = b.z; w[part][d][7] = b.w;
      }
      const f32x4 a = *(const f32x4*)(cbias + part * DFF + c), b = *(const f32x4*)(cbias + part * DFF + c + 4);
      bs[part][0] = a.x; bs[part][1] = a.y; bs[part][2] = a.z; bs[part][3] = a.w; bs[part][4] = b.x; bs[part][5] = b.y; bs[part][6] = b.z; bs[part][7] = b.w;
    }
    const bf16_t* hp = HUP + (size_t)lr0 * (2 * DFF) + c;
    float prev[2][8], cur[2][8], nxt[2][8];
#pragma unroll
    for (int part = 0; part < 2; ++part) {
      if (pos0 > 0) unpack8(*(const u32x4*)(hp - 2 * DFF + part * DFF), prev[part]); else { for (int e = 0; e < 8; ++e) prev[part][e] = 0.f; }
      unpack8(*(const u32x4*)(hp + part * DFF), cur[part]);
    }
#pragma unroll
    for (int r = 0; r < RB; ++r) {
      const bool hasn = pos0 + r < T - 1;
#pragma unroll
      for (int part = 0; part < 2; ++part) {
        if (hasn) unpack8(*(const u32x4*)(hp + (size_t)(r + 1) * (2 * DFF) + part * DFF), nxt[part]); else { for (int e = 0; e < 8; ++e) nxt[part][e] = 0.f; }
      }
      float o[8];
#pragma unroll
      for (int e = 0; e < 8; ++e) {
        const float x = prev[0][e] * w[0][0][e] + cur[0][e] * w[0][1][e] + nxt[0][e] * w[0][2][e] + bs[0][e];
        const float up = prev[1][e] * w[1][0][e] + cur[1][e] * w[1][1][e] + nxt[1][e] * w[1][2][e] + bs[1][e];
        const float u = 0.7978845608028654f * (x + 0.044715f * x * x * x);
        const float t2 = __expf(2.f * u); const float th = 1.f - 2.f / (t2 + 1.f);
        o[e] = 0.5f * x * (1.f + th) * up;
      }
      *(u32x4*)(ACT + (size_t)(lr0 + r) * DFF + c) = pack8(o);
#pragma unroll
      for (int part = 0; part < 2; ++part)
#pragma unroll
        for (int e = 0; e < 8; ++e) { prev[part][e] = cur[part][e]; cur[part][e] = nxt[part][e]; }
    }
  }
}

constexpr int NPHASE = 18;
constexpr int LDS_BYTES = 2 * STAGE8;
static_assert(LDS_BYTES >= 2 * 64 * 65 * 4 && LDS_BYTES >= 9216 + 64 * 68 * 2, "lds");

template <int PH>
DI void run_phase(const Params& p, unsigned char* lds) {
  unsigned char* ws = p.ws;
  if constexpr (PH == 0) phase_prep(p, lds);
  else if constexpr (PH == 1) { EpiScaleStore e{(bf16_t*)p.out, ZLD, (const float*)(ws + OFF_RSTDX), 0};
    gemm_phase((const bf16_t*)(ws + OFF_XB), DM, (const bf16_t*)(ws + OFF_WZT), DM, DM, 0, M_TOK, ZLD, lds, e); }
  else if constexpr (PH == 2) phase_rwprep(p);
  else if constexpr (PH == 3) {
#pragma unroll 1
    for (int d = 0; d < 2; ++d) {
      EpiW ew{(bf16_t*)((unsigned char*)p.out + (size_t)d * SEG), p.in[10] + d * 512};
      gemm_phase((const bf16_t*)(ws + OFF_LIN) + d * 64, LINW, (const bf16_t*)(ws + OFF_W2T) + d * 512 * 64, 64, 64, 0, M_TOK, RWW, lds, ew, d * 128);
      EpiA ea{(bf16_t*)((unsigned char*)p.out + (size_t)(2 + d) * SEG), (bf16_t*)(ws + OFF_BF + (size_t)d * SEG), (const bf16_t*)(ws + OFF_KSH),
              (const bf16_t*)(ws + OFF_NKK), p.in[12] + d * 512, p.in[16]};
      gemm_phase((const bf16_t*)(ws + OFF_LIN) + 128 + d * 64, LINW, (const bf16_t*)(ws + OFF_A2T) + d * 512 * 64, 64, 64, 0, M_TOK, RWW, lds, ea, 128 - d * 128);
    }
    EpiStore eg{(bf16_t*)(ws + OFF_G), RWW};
    gemm_phase((const bf16_t*)(ws + OFF_LIN) + 256, LINW, (const bf16_t*)(ws + OFF_G2T), 160, 160, 0, M_TOK, RWW, lds, eg);
  }
  else if constexpr (PH == 4) { EpiQG e{(bf16_t*)(ws + OFF_QKV), nullptr, (const float*)(ws + OFF_RSTDX)};
    gemm_phase((const bf16_t*)(ws + OFF_XB), DM, (const bf16_t*)(ws + OFF_WQGT), DM, DM, 0, M_TOK, QKVW, lds, e); }
  else if constexpr (PH == 5) {
    const int wid = threadIdx.x >> 6;
    if (wid < 3) phase_scan(p, lds);
    else if ((wid & 3) == 3) phase_attn_wave(p, lds + 3 * SCAN_WLDS + (wid >> 2) * 9216, (int)blockIdx.x * 2 + (wid >> 2), (int)gridDim.x * 2);
  }
  else if constexpr (PH == 6) phase_scan_fix(p, lds);
  else if constexpr (PH == 7) phase_rwfinish(p);
  else if constexpr (PH == 8) { EpiGate e{(bf16_t*)(ws + OFF_SG), (const float*)(ws + OFF_RSTDX)};
    gemm_phase((const bf16_t*)(ws + OFF_XB), DM, (const bf16_t*)(ws + OFF_WQGT) + (size_t)QKVW * DM, DM, DM, 0, M_TOK, SGW, lds, e); }
  else if constexpr (PH == 9) {
    EpiMerge1 e1{(bf16_t*)(ws + OFF_MERGED), (const bf16_t*)(ws + OFF_SG)};
    EpiMerge2 e2{(bf16_t*)(ws + OFF_MERGED), (const bf16_t*)(ws + OFF_SG)};
    const int ntn = DM / T8, ntm = M_TOK / T8;
    for (int t = blockIdx.x; t < ntn * ntm; t += gridDim.x) {
      int tm, tn; tile_of(t, ntm, ntn, tm, tn);
      gemm_tile8((const bf16_t*)(ws + OFF_QKV), QKVW, (const bf16_t*)(ws + OFF_WAT), 512, 512, tm * T8, tn * T8, lds, e1);
    }
    asm volatile("" ::: "memory");
    for (int t = blockIdx.x; t < ntn * ntm; t += gridDim.x) {
      int tm, tn; tile_of(t, ntm, ntn, tm, tn);
      gemm_tile8((const bf16_t*)p.out, 512, (const bf16_t*)(ws + OFF_WBT), 512, 512, tm * T8, tn * T8, lds, e2);
    }
  }
  else if constexpr (PH == 10) { EpiStore e{(bf16_t*)(ws + OFF_MO), DM};
    gemm_phase((const bf16_t*)(ws + OFF_MERGED), DM, (const bf16_t*)(ws + OFF_WOT), DM, DM, 0, M_TOK, DM, lds, e); }
  else if constexpr (PH == 11) phase_row_h(p);
  else if constexpr (PH == 12 || PH == 14) { constexpr int hf = PH == 12 ? 0 : 1;
    EpiScaleStore e{(bf16_t*)(ws + OFF_HUP), 2 * DFF, (const float*)(ws + OFF_RSTDH), hf * HALF_ROWS};
    gemm_phase((const bf16_t*)(ws + OFF_HB), DM, (const bf16_t*)(ws + OFF_WUPT), DM, DM, hf * HALF_ROWS, HALF_ROWS, 2 * DFF, lds, e); }
  else if constexpr (PH == 13 || PH == 15) phase_convglu(p, PH == 13 ? 0 : 1);
  else if constexpr (PH == 16) {
    EpiStore e{(bf16_t*)(ws + OFF_F), DM};
    const bf16_t* A0 = (const bf16_t*)(ws + OFF_ACT);
    const bf16_t* A1 = (const bf16_t*)(ws + OFF_ACT1) - (size_t)HALF_ROWS * DFF;
    const int ntn = DM / T8, ntm = M_TOK / T8;
    for (int t = blockIdx.x; t < ntn * ntm; t += gridDim.x) {
      int tm, tn; tile_of(t, ntm, ntn, tm, tn);
      gemm_tile8(tm * T8 < HALF_ROWS ? A0 : A1, DFF, (const bf16_t*)(ws + OFF_WDNT), DFF, DFF, tm * T8, tn * T8, lds, e);
    }
  }
  else if constexpr (PH == 17) phase_row_out(p);
}

constexpr size_t OFF_BAR = 1016 * MBY;
DI void grid_barrier(const Params& p, int k) {
  __syncthreads();
  if (threadIdx.x == 0) {
    unsigned* base = (unsigned*)(p.ws + OFF_BAR);
    const int g = blockIdx.x & 7, G = gridDim.x, ng = (G - g + 7) >> 3;
    const unsigned ngroups = G < 8 ? G : 8;
    __builtin_amdgcn_fence(__ATOMIC_RELEASE, "agent");
    const unsigned old = __hip_atomic_fetch_add(base + g * 64, 1u, __ATOMIC_RELAXED, __HIP_MEMORY_SCOPE_AGENT);
    if (old + 1 == (unsigned)(k * ng)) __hip_atomic_fetch_add(base + 8 * 64, 1u, __ATOMIC_RELAXED, __HIP_MEMORY_SCOPE_AGENT);
    while (__hip_atomic_load(base + 8 * 64, __ATOMIC_RELAXED, __HIP_MEMORY_SCOPE_AGENT) < (unsigned)k * ngroups) __builtin_amdgcn_s_sleep(1);
    __builtin_amdgcn_fence(__ATOMIC_ACQUIRE, "agent");
  }
  __syncthreads();
}

template <int PH>
DI void run_all(const Params& p, unsigned char* lds) {
  run_phase<PH>(p, lds);
  if constexpr (((DUP_MASK >> PH) & 1) != 0) { __syncthreads(); run_phase<PH>(p, lds); }
  if constexpr (PH + 1 < NPHASE) {
    if constexpr (PH == 0) cg::this_grid().sync();
    else grid_barrier(p, PH);
    run_all<PH + 1>(p, lds);
  }
}

__global__ void __launch_bounds__(512) mega_coop(Params p) {
  __shared__ __attribute__((aligned(16))) unsigned char lds[LDS_BYTES];
  if (blockIdx.x == 0 && threadIdx.x < 16) __hip_atomic_store((unsigned*)(p.ws + OFF_BAR) + threadIdx.x * 64, 0u, __ATOMIC_RELAXED, __HIP_MEMORY_SCOPE_AGENT);
  run_all<0>(p, lds);
}

template <int PH>
__global__ void __launch_bounds__(512) mega_one(Params p) {
  __shared__ __attribute__((aligned(16))) unsigned char lds[LDS_BYTES];
  run_phase<PH>(p, lds);
}

template <int PH>
static void launch_all(const Params& p, int grid, hipStream_t stream) {
  hipLaunchKernelGGL(mega_one<PH>, dim3(grid), dim3(NTHR), 0, stream, p);
  if constexpr (PH + 1 < NPHASE) launch_all<PH + 1>(p, grid, stream);
}

extern "C" void kernel_launch(void* const* d_in, const int* in_sizes, int n_in, void* d_out, int out_size, void* d_ws, size_t ws_size,
                              hipStream_t stream) {
  static int grid_blocks = 0;
  if (!grid_blocks) {
    int dev = 0, cus = 0, per_cu = 0;
    (void)hipGetDevice(&dev);
    (void)hipDeviceGetAttribute(&cus, hipDeviceAttributeMultiprocessorCount, dev);
    (void)hipOccupancyMaxActiveBlocksPerMultiprocessor(&per_cu, mega_coop, NTHR, 0);
    if (per_cu < 1) per_cu = 1;
    if (per_cu > 1) per_cu = 1;
    grid_blocks = cus * per_cu;
    if (ws_size < 1014 * MBY) fprintf(stderr, "kernel_launch: workspace too small (%zu)\n", ws_size);
  }
  Params p{};
  for (int i = 0; i < 27; ++i) p.in[i] = (const float*)d_in[i];
  p.out = (float*)d_out; p.ws = (unsigned char*)d_ws;
  if (COOP_MODE) {
    void* args[] = {&p};
    hipError_t e = hipLaunchCooperativeKernel((void*)mega_coop, dim3(grid_blocks), dim3(NTHR), args, 0, stream);
    if (e != hipSuccess) fprintf(stderr, "cooperative launch failed: %s (grid %d)\n", hipGetErrorString(e), grid_blocks);
  } else {
    launch_all<0>(p, grid_blocks, stream);
  }
}
```

```cpp
#include <hip/hip_runtime.h>
#include <hip/hip_cooperative_groups.h>
#include <cstdint>
#include <cstdio>
namespace cg = cooperative_groups;

#ifndef NAIVE_GEMM
#define NAIVE_GEMM 0
#endif
#ifndef NAIVE_TR
#define NAIVE_TR 0
#endif
#ifndef DUP_MASK
#define DUP_MASK 0
#endif
#ifndef COOP_MODE
#define COOP_MODE 1
#endif

typedef unsigned short bf16_t;
typedef short bf16x8 __attribute__((ext_vector_type(8)));
typedef short s16x4 __attribute__((ext_vector_type(4)));
typedef float f32x4 __attribute__((ext_vector_type(4)));
typedef float f32x2 __attribute__((ext_vector_type(2)));
typedef unsigned u32x4 __attribute__((ext_vector_type(4)));
typedef unsigned u32x2 __attribute__((ext_vector_type(2)));
typedef __bf16 bf16x2_t __attribute__((ext_vector_type(2)));
#define DI __device__ __forceinline__

constexpr int M_TOK = 81920, DM = 1024, T_P = 16384, T_S = 2048;
constexpr int IN_W = 4768, RWW = 512, DFF = 2816, ZW = 1952, ZLD = 2048, LINW = 416, QKVW = 768, SGW = 2048;
constexpr int HALF_ROWS = 40960;
constexpr int NTHR = 512, NWV = NTHR / 64;
constexpr size_t MBY = 1ull << 20;
constexpr size_t OFF_WZT = 0, OFF_WQGT = 4 * MBY, OFF_WAT = OFF_WQGT + 2816ull * 1024 * 2, OFF_WBT = OFF_WAT + MBY, OFF_WOT = OFF_WBT + MBY,
                 OFF_WUPT = OFF_WOT + 2 * MBY, OFF_WDNT = OFF_WUPT + 11 * MBY, OFF_W2T = 30 * MBY, OFF_A2T = OFF_W2T + 128 * 1024,
                 OFF_G2T = OFF_A2T + 128 * 1024;
constexpr size_t OFF_RSTDX = 32 * MBY, OFF_RSTDH = 33 * MBY;
constexpr size_t OFF_XB = 34 * MBY;
constexpr size_t OFF_R = 194 * MBY, OFF_V = 274 * MBY, OFF_NKK = 354 * MBY, OFF_BF = 434 * MBY  ;
constexpr size_t OFF_KSH = 594 * MBY, OFF_LIN = 674 * MBY, OFF_G = 739 * MBY, OFF_YS = 819 * MBY  ;
constexpr size_t OFF_QKV = 594 * MBY  , OFF_MERGED = 714 * MBY  , OFF_SG = 194 * MBY  ;
constexpr size_t OFF_MO = OFF_XB, OFF_HB = 194 * MBY, OFF_HUP = 354 * MBY  , OFF_ACT = 794 * MBY  , OFF_ACT1 = 34 * MBY  , OFF_F = 354 * MBY  ;
constexpr size_t SEG = (size_t)M_TOK * 512 * 2;

struct Params { const float* in[27]; float* out; unsigned char* ws; };

DI unsigned pk2(float lo, float hi) { f32x2 v = {lo, hi}; bf16x2_t b = __builtin_convertvector(v, bf16x2_t); return __builtin_bit_cast(unsigned, b); }
DI float lo2f(unsigned u) { return __uint_as_float(u << 16); }
DI float hi2f(unsigned u) { return __uint_as_float(u & 0xffff0000u); }
DI float bf2f(bf16_t v) { return __uint_as_float(((unsigned)v) << 16); }
DI void unpack8(const u32x4 u, float* f) { f[0] = lo2f(u.x); f[1] = hi2f(u.x); f[2] = lo2f(u.y); f[3] = hi2f(u.y); f[4] = lo2f(u.z); f[5] = hi2f(u.z); f[6] = lo2f(u.w); f[7] = hi2f(u.w); }
DI u32x4 pack8(const float* f) { u32x4 u; u.x = pk2(f[0], f[1]); u.y = pk2(f[2], f[3]); u.z = pk2(f[4], f[5]); u.w = pk2(f[6], f[7]); return u; }
DI float sigmoidf_(float x) { return 1.f / (1.f + __expf(-x)); }
DI float wave_sum(float v) {
#pragma unroll
  for (int o = 32; o >= 1; o >>= 1) v += __shfl_xor(v, o);
  return v;
}
DI void seq_of(int row, int& start, int& T) { if (row < T_P) { start = 0; T = T_P; } else { start = T_P + ((row - T_P) / T_S) * T_S; T = T_S; } }

DI void transpose_job(const float* __restrict__ src, int srcN, int K, int n0, int ncols, int ncols_pad, bf16_t* __restrict__ dst,
                              const float* __restrict__ scale, float* lds) {
  const int ntn = (ncols_pad + 63) / 64, ntk = (K + 63) / 64, tid = threadIdx.x;
  if (NAIVE_TR) {
    for (size_t idx = (size_t)blockIdx.x * NTHR + tid; idx < (size_t)ncols_pad * K; idx += (size_t)gridDim.x * NTHR) {
      const int n = (int)(idx / K), k = (int)(idx % K);
      float v = 0.f;
      if (n < ncols) { v = src[(size_t)k * srcN + n0 + n]; if (scale) v *= scale[k]; }
      dst[idx] = (bf16_t)(pk2(v, 0.f) & 0xffffu);
    }
    return;
  }
  for (int t = blockIdx.x; t < ntn * ntk; t += gridDim.x) {
    const int tk = t % ntk, tn = t / ntk;
#pragma unroll
    for (int i = 0; i < 64 / NWV; ++i) {
      const int kk = i * NWV + (tid >> 6), nn = tid & 63, k = tk * 64 + kk, n = tn * 64 + nn;
      float v = 0.f;
      if (k < K && n < ncols) { v = src[(size_t)k * srcN + n0 + n]; if (scale) v *= scale[k]; }
      lds[kk * 65 + nn] = v;
    }
    __syncthreads();
#pragma unroll
    for (int i = 0; i < 64 / NWV; ++i) {
      const int nn = i * NWV + (tid >> 6), kk = tid & 63, k = tk * 64 + kk, n = tn * 64 + nn;
      if (k < K && n < ncols_pad) { unsigned u = pk2(lds[kk * 65 + nn], 0.f); dst[(size_t)n * K + k] = (bf16_t)(u & 0xffffu); }
    }
    __syncthreads();
  }
}

DI void phase_prep(const Params& p, unsigned char* ldsb) {
  float* lds = (float*)ldsb;
  unsigned char* ws = p.ws;
  transpose_job(p.in[6], IN_W, 1024, 768, ZW, ZLD, (bf16_t*)(ws + OFF_WZT), p.in[2], lds);
  transpose_job(p.in[6], IN_W, 1024, 0, 768, 768, (bf16_t*)(ws + OFF_WQGT), p.in[2], lds);
  transpose_job(p.in[6], IN_W, 1024, 2720, 2048, 2048, (bf16_t*)(ws + OFF_WQGT) + 768 * 1024, p.in[2], lds);
  transpose_job(p.in[20], 1024, 512, 0, 1024, 1024, (bf16_t*)(ws + OFF_WAT), nullptr, lds);
  transpose_job(p.in[21], 1024, 512, 0, 1024, 1024, (bf16_t*)(ws + OFF_WBT), nullptr, lds);
  transpose_job(p.in[22], 1024, 1024, 0, 1024, 1024, (bf16_t*)(ws + OFF_WOT), nullptr, lds);
  transpose_job(p.in[23], 2 * DFF, 1024, 0, 2 * DFF, 2 * DFF, (bf16_t*)(ws + OFF_WUPT), p.in[4], lds);
  transpose_job(p.in[26], 1024, DFF, 0, 1024, 1024, (bf16_t*)(ws + OFF_WDNT), nullptr, lds);
  for (int d = 0; d < 2; ++d) {
    transpose_job(p.in[11] + d * 64 * 512, 512, 64, 0, 512, 512, (bf16_t*)(ws + OFF_W2T) + d * 512 * 64, nullptr, lds);
    transpose_job(p.in[13] + d * 64 * 512, 512, 64, 0, 512, 512, (bf16_t*)(ws + OFF_A2T) + d * 512 * 64, nullptr, lds);
  }
  transpose_job(p.in[14], 512, 160, 0, 512, 512, (bf16_t*)(ws + OFF_G2T), nullptr, lds);
  const int lane = threadIdx.x & 63, gw = blockIdx.x * NWV + (threadIdx.x >> 6), nw = gridDim.x * NWV;
  bf16_t* xb = (bf16_t*)(ws + OFF_XB);
  float* rstd = (float*)(ws + OFF_RSTDX);
  for (int row = gw; row < M_TOK; row += nw) {
    const float* src = row < T_P ? p.in[0] + (size_t)row * DM : p.in[1] + (size_t)(row - T_P) * DM;
    float ss = 0.f;
#pragma unroll
    for (int i = 0; i < 4; ++i) {
      const int c = (i * 64 + lane) * 4;
      const f32x4 v = *(const f32x4*)(src + c);
      ss += v.x * v.x + v.y * v.y + v.z * v.z + v.w * v.w;
      u32x2 o; o.x = pk2(v.x, v.y); o.y = pk2(v.z, v.w);
      *(u32x2*)(xb + (size_t)row * DM + c) = o;
    }
    ss = wave_sum(ss);
    if (lane == 0) rstd[row] = rsqrtf(ss * (1.f / DM) + 1e-6f);
  }
}

constexpr int LROW = 80;
template <int MT, int NT, class Epi>
DI void gemm_tile(const bf16_t* __restrict__ A, int lda, const bf16_t* __restrict__ Bt, int ldb, int K, int row0, int col0,
                  unsigned char* lds, Epi& epi) {
  constexpr int BM = 32 * MT, BN = 32 * NT, STAGE = (BM + BN) * LROW, ACH = BM * 4 / 256, BCH = BN * 4 / 256;
  const int tid = threadIdx.x, lane = tid & 63, wid = tid >> 6, wm = wid >> 1, wn = wid & 1, fr = lane & 15, fq = lane >> 4;
  f32x4 acc[MT][NT];
#pragma unroll
  for (int i = 0; i < MT; ++i)
#pragma unroll
    for (int j = 0; j < NT; ++j) acc[i][j] = (f32x4){0.f, 0.f, 0.f, 0.f};
  u32x4 ra[ACH], rb[BCH];
  const bf16_t* ap[ACH]; const bf16_t* bp[BCH];
#pragma unroll
  for (int i = 0; i < ACH; ++i) { const int c = tid + i * 256; ap[i] = A + (size_t)(row0 + (c >> 2)) * lda + (c & 3) * 8; }
#pragma unroll
  for (int i = 0; i < BCH; ++i) { const int c = tid + i * 256; bp[i] = Bt + (size_t)(col0 + (c >> 2)) * ldb + (c & 3) * 8; }
  const int nk = K / 32;
#pragma unroll
  for (int i = 0; i < ACH; ++i) ra[i] = *(const u32x4*)(ap[i]);
#pragma unroll
  for (int i = 0; i < BCH; ++i) rb[i] = *(const u32x4*)(bp[i]);
#pragma unroll
  for (int i = 0; i < ACH; ++i) { const int c = tid + i * 256; *(u32x4*)(lds + (c >> 2) * LROW + (c & 3) * 16) = ra[i]; }
#pragma unroll
  for (int i = 0; i < BCH; ++i) { const int c = tid + i * 256; *(u32x4*)(lds + BM * LROW + (c >> 2) * LROW + (c & 3) * 16) = rb[i]; }
  __syncthreads();
  for (int kt = 0; kt < nk; ++kt) {
    const bool more = kt + 1 < nk;
    if (more) {
#pragma unroll
      for (int i = 0; i < ACH; ++i) ra[i] = *(const u32x4*)(ap[i] + (kt + 1) * 32);
#pragma unroll
      for (int i = 0; i < BCH; ++i) rb[i] = *(const u32x4*)(bp[i] + (kt + 1) * 32);
    }
    const unsigned char* sa = lds + (kt & 1) * STAGE;
    const unsigned char* sb = sa + BM * LROW;
    bf16x8 af[MT], bfv[NT];
#pragma unroll
    for (int i = 0; i < MT; ++i) af[i] = *(const bf16x8*)(sa + (wm * MT * 16 + i * 16 + fr) * LROW + fq * 16);
#pragma unroll
    for (int j = 0; j < NT; ++j) bfv[j] = *(const bf16x8*)(sb + (wn * NT * 16 + j * 16 + fr) * LROW + fq * 16);
#pragma unroll
    for (int i = 0; i < MT; ++i)
#pragma unroll
      for (int j = 0; j < NT; ++j) acc[i][j] = __builtin_amdgcn_mfma_f32_16x16x32_bf16(bfv[j], af[i], acc[i][j], 0, 0, 0);
    if (more) {
      unsigned char* da = lds + ((kt + 1) & 1) * STAGE;
#pragma unroll
      for (int i = 0; i < ACH; ++i) { const int c = tid + i * 256; *(u32x4*)(da + (c >> 2) * LROW + (c & 3) * 16) = ra[i]; }
#pragma unroll
      for (int i = 0; i < BCH; ++i) { const int c = tid + i * 256; *(u32x4*)(da + BM * LROW + (c >> 2) * LROW + (c & 3) * 16) = rb[i]; }
    }
    __syncthreads();
  }
#pragma unroll
  for (int i = 0; i < MT; ++i)
#pragma unroll
    for (int j = 0; j < NT; ++j) epi(row0 + wm * MT * 16 + i * 16 + fr, col0 + wn * NT * 16 + j * 16 + fq * 4, acc[i][j]);
}


#ifndef NAIVE_GEMM
#define NAIVE_GEMM 0
#endif
#ifndef NAIVE_TR
#define NAIVE_TR 0
#endif
template <int MT, int NT, class Epi>
DI void gemm_tile_naive(const bf16_t* A, int lda, const bf16_t* Bt, int ldb, int K, int row0, int col0, Epi& epi) {
  const int tid = threadIdx.x, lane = tid & 63, wid = tid >> 6, wm = wid >> 1, wn = wid & 1, fr = lane & 15, fq = lane >> 4;
  for (int i = 0; i < MT; ++i)
    for (int j = 0; j < NT; ++j) {
      const int row = row0 + wm * MT * 16 + i * 16 + fr, col = col0 + wn * NT * 16 + j * 16 + fq * 4;
      f32x4 acc = {0.f, 0.f, 0.f, 0.f};
      for (int k = 0; k < K; k += 8) {
        float a[8]; unpack8(*(const u32x4*)(A + (size_t)row * lda + k), a);
#pragma unroll
        for (int jj = 0; jj < 4; ++jj) { float b[8]; unpack8(*(const u32x4*)(Bt + (size_t)(col + jj) * ldb + k), b);
#pragma unroll
          for (int e = 0; e < 8; ++e) acc[jj] += a[e] * b[e]; }
      }
      epi(row, col, acc);
    }
}
DI void store4(bf16_t* ptr, f32x4 v) { u32x2 o; o.x = pk2(v.x, v.y); o.y = pk2(v.z, v.w); *(u32x2*)ptr = o; }
DI f32x4 load4(const bf16_t* ptr) { const u32x2 u = *(const u32x2*)ptr; return (f32x4){lo2f(u.x), hi2f(u.x), lo2f(u.y), hi2f(u.y)}; }

constexpr int GMT = 8, GNT = 4, GBM = 32 * GMT, GBN = 32 * GNT;

struct EpiScaleStore { bf16_t* O; int ldo; const float* rstd; int rowoff;
  DI void operator()(int row, int col, f32x4 v) { const float s = rstd[row]; store4(O + (size_t)(row - rowoff) * ldo + col, v * s); } };
struct EpiQG { bf16_t* qkv; bf16_t* sg; const float* rstd;
  DI void operator()(int row, int col, f32x4 v) { const float s = rstd[row]; v = v * s;
    if (col < QKVW) store4(qkv + (size_t)row * QKVW + col, v);
    else { f32x4 g = {sigmoidf_(v.x), sigmoidf_(v.y), sigmoidf_(v.z), sigmoidf_(v.w)}; store4(sg + (size_t)row * SGW + (col - QKVW), g); } } };
struct EpiGate { bf16_t* sg; const float* rstd;
  DI void operator()(int row, int col, f32x4 v) { const float s = rstd[row]; v = v * s;
    f32x4 g = {sigmoidf_(v.x), sigmoidf_(v.y), sigmoidf_(v.z), sigmoidf_(v.w)}; store4(sg + (size_t)row * SGW + col, g); } };
struct EpiW { bf16_t* O; const float* w0;
  DI void operator()(int row, int col, f32x4 v) { f32x4 o;
#pragma unroll
    for (int j = 0; j < 4; ++j) { const float x = w0[col + j] + v[j]; const float sp = fmaxf(-x, 0.f) + __logf(1.f + __expf(-fabsf(x)));
      const float e = __expf(-sp - 0.5f); o[j] = 1.f - __expf(-e); }
    store4(O + (size_t)row * RWW + col, o); } };
struct EpiA { bf16_t* KO; bf16_t* BO; const bf16_t* ksh; const bf16_t* nkk; const float* a0; const float* k_a;
  DI void operator()(int row, int col, f32x4 v) { const f32x4 k = load4(ksh + (size_t)row * RWW + col), nk = load4(nkk + (size_t)row * RWW + col); f32x4 ko, bo;
#pragma unroll
    for (int j = 0; j < 4; ++j) { const float a = sigmoidf_(a0[col + j] + v[j]); ko[j] = k[j] * (1.f + (a - 1.f) * k_a[col + j]); bo[j] = -nk[j] * a; }
    store4(KO + (size_t)row * RWW + col, ko); store4(BO + (size_t)row * RWW + col, bo); } };
struct EpiStore { bf16_t* O; int ldo;
  DI void operator()(int row, int col, f32x4 v) { store4(O + (size_t)row * ldo + col, v); } };
struct EpiMerge1 { bf16_t* O; const bf16_t* sg;
  DI void operator()(int row, int col, f32x4 v) { const f32x4 g = load4(sg + (size_t)row * SGW + col); store4(O + (size_t)row * DM + col, v * g); } };
struct EpiMerge2 { bf16_t* O; const bf16_t* sg;
  DI void operator()(int row, int col, f32x4 v) { const f32x4 g = load4(sg + (size_t)row * SGW + 1024 + col); bf16_t* o = O + (size_t)row * DM + col; const f32x4 prev = load4(o); store4(o, prev + v * g); } };

constexpr int LROW8 = 144, T8 = 256, STAGE8 = 2 * T8 * LROW8;
template <class Epi>
DI void gemm_tile8(const bf16_t* __restrict__ A, int lda, const bf16_t* __restrict__ Bt, int ldb, int K, int row0, int col0,
                   unsigned char* lds, Epi& epi) {
  const int tid = threadIdx.x, lane = tid & 63, wid = tid >> 6, wm = wid >> 2, wn = wid & 3, fr = lane & 15, fq = lane >> 4;
  f32x4 acc[8][4];
#pragma unroll
  for (int i = 0; i < 8; ++i)
#pragma unroll
    for (int j = 0; j < 4; ++j) acc[i][j] = (f32x4){0.f, 0.f, 0.f, 0.f};
  u32x4 ra[4], rb[4];
  const int lrow = tid >> 3, lkc = tid & 7;
  const bf16_t* ap = A + (size_t)(row0 + lrow) * lda + lkc * 8;
  const bf16_t* bp = Bt + (size_t)(col0 + lrow) * ldb + lkc * 8;
  const size_t astep = (size_t)64 * lda, bstep = (size_t)64 * ldb;
  unsigned char* wa = lds + lrow * LROW8 + lkc * 16;
  const int nk = K / 64, krem = K & 63;
#pragma unroll
  for (int i = 0; i < 4; ++i) ra[i] = *(const u32x4*)(ap + i * astep);
#pragma unroll
  for (int i = 0; i < 4; ++i) rb[i] = *(const u32x4*)(bp + i * bstep);
#pragma unroll
  for (int i = 0; i < 4; ++i) *(u32x4*)(wa + i * 64 * LROW8) = ra[i];
#pragma unroll
  for (int i = 0; i < 4; ++i) *(u32x4*)(wa + T8 * LROW8 + i * 64 * LROW8) = rb[i];
  __syncthreads();
  const int nkt = nk + (krem ? 1 : 0);
  for (int kt = 0; kt < nkt; ++kt) {
    const bool more = kt + 1 < nkt;
    const unsigned char* sa = lds + (kt & 1) * STAGE8 + (wm * 128 + fr) * LROW8 + fq * 16;
    const unsigned char* sb = lds + (kt & 1) * STAGE8 + T8 * LROW8 + (wn * 64 + fr) * LROW8 + fq * 16;
    const int nsub = (kt == nk) ? 1 : 2;
#pragma unroll
    for (int ks = 0; ks < 2; ++ks) {
      if (ks < nsub) {
        bf16x8 bfv[4];
#pragma unroll
        for (int j = 0; j < 4; ++j) bfv[j] = *(const bf16x8*)(sb + j * 16 * LROW8 + ks * 64);
#pragma unroll
        for (int ih = 0; ih < 2; ++ih) {
          bf16x8 af[4];
#pragma unroll
          for (int i = 0; i < 4; ++i) af[i] = *(const bf16x8*)(sa + (ih * 4 + i) * 16 * LROW8 + ks * 64);
#pragma unroll
          for (int i = 0; i < 4; ++i)
#pragma unroll
            for (int j = 0; j < 4; ++j) acc[ih * 4 + i][j] = __builtin_amdgcn_mfma_f32_16x16x32_bf16(bfv[j], af[i], acc[ih * 4 + i][j], 0, 0, 0);
          if (ks == 0) {
            asm volatile("" ::: "memory");
            if (more) {
              const int koff = (kt + 1) * 64 - ((kt + 1 == nk && krem && lkc >= 4) ? 32 : 0);
              if (ih == 0) {
#pragma unroll
                for (int i = 0; i < 4; ++i) ra[i] = *(const u32x4*)(ap + i * astep + koff);
              } else {
#pragma unroll
                for (int i = 0; i < 4; ++i) rb[i] = *(const u32x4*)(bp + i * bstep + koff);
              }
            }
            asm volatile("" ::: "memory");
          }
        }
      }
    }
    if (more) {
      unsigned char* da = wa + ((kt + 1) & 1) * STAGE8;
#pragma unroll
      for (int i = 0; i < 4; ++i) *(u32x4*)(da + i * 64 * LROW8) = ra[i];
#pragma unroll
      for (int i = 0; i < 4; ++i) *(u32x4*)(da + T8 * LROW8 + i * 64 * LROW8) = rb[i];
    }
    __syncthreads();
  }
#pragma unroll
  for (int i = 0; i < 8; ++i)
#pragma unroll
    for (int j = 0; j < 4; ++j) epi(row0 + wm * 128 + i * 16 + fr, col0 + wn * 64 + j * 16 + fq * 4, acc[i][j]);
}

DI void tile_of(int t, int ntm, int ntn, int& tm, int& tn) {
  const int G = gridDim.x;
  if ((G & 7) == 0 && (ntm & 31) == 0) {
    const int x = t & 7, l = (t >> 3), mper = ntm >> 3;
    const int gs = (mper & 7) == 0 ? 8 : 4;
    const int grp = l / (gs * ntn), r = l % (gs * ntn);
    tm = x * mper + grp * gs + (r % gs); tn = r / gs;
  } else { tm = t / ntn; tn = t % ntn; }
}
template <int MT = 0, class Epi>
DI void gemm_phase(const bf16_t* A, int lda, const bf16_t* Bt, int ldb, int K, int rows0, int nrows, int N, unsigned char* lds, Epi& epi, int rot = 0) {
  const int ntn = N / T8, ntm = nrows / T8;
  for (int t = (int)((blockIdx.x + rot) % gridDim.x); t < ntn * ntm; t += gridDim.x) {
    int tm, tn; tile_of(t, ntm, ntn, tm, tn);
    gemm_tile8(A, lda, Bt, ldb, K, rows0 + tm * T8, tn * T8, lds, epi);
  }
}

DI void phase_rwprep(const Params& p) {
  unsigned char* ws = p.ws;
  const bf16_t* z = (const bf16_t*)p.out;
  bf16_t* R = (bf16_t*)(ws + OFF_R); bf16_t* V = (bf16_t*)(ws + OFF_V); bf16_t* NKK = (bf16_t*)(ws + OFF_NKK);
  bf16_t* KSH = (bf16_t*)(ws + OFF_KSH); bf16_t* LIN = (bf16_t*)(ws + OFF_LIN);
  const float* mup = p.in[8]; const float* mun = p.in[9]; const float* k_k = p.in[15];
  const int lane = threadIdx.x & 63, gw = blockIdx.x * NWV + (threadIdx.x >> 6), nw = gridDim.x * NWV;
  constexpr int RB = 8;
  for (int rbk = gw; rbk < M_TOK / RB; rbk += nw) {
    const int row0 = rbk * RB;
    int start, T; seq_of(row0, start, T);
    const int pos0 = row0 - start;
#pragma unroll
    for (int seg = 0; seg < 4; ++seg) {
      const int c = seg < 3 ? seg * 512 + lane * 8 : 1536 + lane * 8;
      if (seg == 3 && lane >= 52) break;
      float mp[8], mn[8], kkw[8];
#pragma unroll
      for (int e = 0; e < 8; ++e) { mp[e] = mup[c + e]; mn[e] = mun[c + e]; kkw[e] = seg == 1 ? k_k[lane * 8 + e] : 0.f; }
      const bf16_t* zr = z + (size_t)row0 * ZLD + c;
      float zp[8], zc[8], zn[8], zs[8];
      if (pos0 > 0) unpack8(*(const u32x4*)(zr - ZLD), zp); else { for (int e = 0; e < 8; ++e) zp[e] = 0.f; }
      unpack8(*(const u32x4*)zr, zc);
#pragma unroll
      for (int r = 0; r < RB; ++r) {
        const int row = row0 + r;
        if (pos0 + r < T - 1) unpack8(*(const u32x4*)(zr + (size_t)(r + 1) * ZLD), zn); else { for (int e = 0; e < 8; ++e) zn[e] = 0.f; }
#pragma unroll
        for (int e = 0; e < 8; ++e) zs[e] = zc[e] + mp[e] * (zp[e] - zc[e]) + mn[e] * (zn[e] - zc[e]);
        if (seg == 0) *(u32x4*)(R + (size_t)row * RWW + lane * 8) = pack8(zs);
        else if (seg == 2) *(u32x4*)(V + (size_t)row * RWW + lane * 8) = pack8(zs);
        else if (seg == 1) {
          *(u32x4*)(KSH + (size_t)row * RWW + lane * 8) = pack8(zs);
          float kk[8], ss = 0.f;
#pragma unroll
          for (int e = 0; e < 8; ++e) { kk[e] = zs[e] * kkw[e]; ss += kk[e] * kk[e]; }
          ss += __shfl_xor(ss, 1); ss += __shfl_xor(ss, 2); ss += __shfl_xor(ss, 4);
          const float inv = -1.f / fmaxf(sqrtf(ss), 1e-12f);
#pragma unroll
          for (int e = 0; e < 8; ++e) kk[e] *= inv;
          *(u32x4*)(NKK + (size_t)row * RWW + lane * 8) = pack8(kk);
        } else {
#pragma unroll
          for (int e = 0; e < 8; ++e) {
            if (lane < 16) { const float t2 = __expf(2.f * zs[e]); zs[e] = 1.f - 2.f / (t2 + 1.f); }
            else if (lane >= 32) zs[e] = sigmoidf_(zs[e]);
          }
          *(u32x4*)(LIN + (size_t)row * LINW + lane * 8) = pack8(zs);
        }
#pragma unroll
        for (int e = 0; e < 8; ++e) { zp[e] = zc[e]; zc[e] = zn[e]; }
      }
    }
  }
}

DI float dpp_xor1(float v) { return __builtin_bit_cast(float, __builtin_amdgcn_update_dpp(0, __builtin_bit_cast(int, v), 0xB1, 0xF, 0xF, false)); }
DI float dpp_xor2(float v) { return __builtin_bit_cast(float, __builtin_amdgcn_update_dpp(0, __builtin_bit_cast(int, v), 0x4E, 0xF, 0xF, false)); }
struct ScanRaw { u32x4 r[2], w[2], k[2], a[2], b[2]; u32x2 v; };
DI void unpack16_2(const u32x4* u, f32x2* f) {
#pragma unroll
  for (int i = 0; i < 2; ++i) { f[i * 4 + 0] = (f32x2){lo2f(u[i].x), hi2f(u[i].x)}; f[i * 4 + 1] = (f32x2){lo2f(u[i].y), hi2f(u[i].y)};
    f[i * 4 + 2] = (f32x2){lo2f(u[i].z), hi2f(u[i].z)}; f[i * 4 + 3] = (f32x2){lo2f(u[i].w), hi2f(u[i].w)}; }
}
constexpr int NCH = 8, CHL = T_P / NCH;
constexpr size_t OFF_QB = 979 * MBY  , OFF_ST = 1011 * MBY  ;
constexpr int SCAN_TS = 8, SCAN_WLDS = SCAN_TS * 6 * 64 * 4;
DI void phase_scan(const Params& p, unsigned char* ldsb) {
  unsigned char* ws = p.ws;
  const bf16_t* R = (const bf16_t*)(ws + OFF_R); const bf16_t* V = (const bf16_t*)(ws + OFF_V); const bf16_t* NKK = (const bf16_t*)(ws + OFF_NKK);
  const int wid = threadIdx.x >> 6, lane = threadIdx.x & 63, rg = lane >> 2, cgp = lane & 3;
  float* L = (float*)(ldsb + wid * SCAN_WLDS);
  const int sst = lane >> 3, sch = lane & 7;
  constexpr int NCHAIN = 32 * 16 + NCH * 16 * 2;
  for (int chain = blockIdx.x * 3 + wid; wid < 3 && chain < NCHAIN; chain += 3 * gridDim.x) {
    int hd, start, T, i0, mode, cidx = 0;
    if (chain < 512) { hd = chain & 15; start = T_P + (chain >> 4) * T_S; T = T_S; i0 = 0; mode = 0; }
    else { const int pc = chain - 512; mode = pc & 1; hd = (pc >> 1) & 15; cidx = pc >> 5; start = 0; T = T_P; i0 = cidx * CHL; }
    const int h = hd >> 1, d = hd & 1;
    const bf16_t* Wd = (const bf16_t*)((const unsigned char*)p.out + (size_t)d * SEG);
    const bf16_t* Kd = (const bf16_t*)((const unsigned char*)p.out + (size_t)(2 + d) * SEG);
    const bf16_t* Bd = (const bf16_t*)(ws + OFF_BF + (size_t)d * SEG);
    bf16_t* YS = mode ? (bf16_t*)(ws + OFF_QB + (size_t)d * T_P * RWW * 2) : (bf16_t*)(ws + OFF_YS + (size_t)d * SEG);
    const int rb = h * 64 + rg * 4;
    f32x2 S[4][8];
#pragma unroll
    for (int r = 0; r < 4; ++r)
#pragma unroll
      for (int c = 0; c < 8; ++c) {
        const int row = rg * 4 + r, col = cgp * 16 + 2 * c;
        S[r][c] = (f32x2){(mode && row == col) ? 1.f : 0.f, (mode && row == col + 1) ? 1.f : 0.f};
      }
    u32x4 g[6];
    auto gload = [&](int ic) {
      const int i = ic + sst, t = d ? T - 1 - i : i; const size_t o = (size_t)(start + t) * RWW + h * 64 + sch * 8;
      g[0] = *(const u32x4*)(NKK + o); g[1] = *(const u32x4*)(Wd + o); g[2] = *(const u32x4*)(Bd + o);
      g[3] = *(const u32x4*)(Kd + o); g[4] = *(const u32x4*)(R + o); g[5] = *(const u32x4*)(V + o);
    };
    auto lwrite = [&]() {
#pragma unroll
      for (int x = 0; x < 6; ++x) {
        float f[8]; unpack8(g[x], f);
        if (x == 1) { for (int e = 0; e < 8; ++e) f[e] = 1.f - f[e]; }
        if (x == 5 && mode) { for (int e = 0; e < 8; ++e) f[e] = 0.f; }
        float* dst = L + sst * 384 + x * 64 + sch * 8;
        *(f32x4*)dst = (f32x4){f[0], f[1], f[2], f[3]}; *(f32x4*)(dst + 4) = (f32x4){f[4], f[5], f[6], f[7]};
      }
    };
    gload(i0); lwrite();
    const int iend = i0 + T_S;
#pragma unroll 1
    for (int ic = i0; ic < iend; ic += SCAN_TS) {
      const bool more = ic + SCAN_TS < iend;
      if (more) gload(ic + SCAN_TS);
#pragma unroll
      for (int s = 0; s < SCAN_TS; ++s) {
        const float* Ls = L + s * 384;
        const f32x4 vq = *(const f32x4*)(Ls + 5 * 64 + rg * 4);
        const float vv[4] = {vq.x, vq.y, vq.z, vq.w};
        f32x2 sa2[4], y2[4];
        {
          f32x2 aa[8];
#pragma unroll
          for (int q = 0; q < 4; ++q) { const f32x4 t4 = *(const f32x4*)(Ls + 0 * 64 + cgp * 16 + q * 4); aa[2 * q] = (f32x2){t4.x, t4.y}; aa[2 * q + 1] = (f32x2){t4.z, t4.w}; }
#pragma unroll
          for (int r = 0; r < 4; ++r) {
            f32x2 s2 = S[r][0] * aa[0];
#pragma unroll
            for (int c = 1; c < 8; ++c) s2 += S[r][c] * aa[c];
            float sa = s2.x + s2.y;
            sa += dpp_xor1(sa); sa += dpp_xor2(sa);
            sa2[r] = (f32x2){sa, sa}; y2[r] = (f32x2){0.f, 0.f};
          }
        }
#pragma unroll
        for (int q = 0; q < 4; ++q) {
          const f32x4 w4 = *(const f32x4*)(Ls + 1 * 64 + cgp * 16 + q * 4), b4 = *(const f32x4*)(Ls + 2 * 64 + cgp * 16 + q * 4);
          const f32x4 k4 = *(const f32x4*)(Ls + 3 * 64 + cgp * 16 + q * 4), r4 = *(const f32x4*)(Ls + 4 * 64 + cgp * 16 + q * 4);
#pragma unroll
          for (int hh = 0; hh < 2; ++hh) {
            const int c = 2 * q + hh;
            const f32x2 w = hh ? (f32x2){w4.z, w4.w} : (f32x2){w4.x, w4.y}, b = hh ? (f32x2){b4.z, b4.w} : (f32x2){b4.x, b4.y};
            const f32x2 k = hh ? (f32x2){k4.z, k4.w} : (f32x2){k4.x, k4.y}, rr = hh ? (f32x2){r4.z, r4.w} : (f32x2){r4.x, r4.y};
#pragma unroll
            for (int r = 0; r < 4; ++r) {
              const f32x2 v2 = {vv[r], vv[r]};
              S[r][c] = S[r][c] * w + (sa2[r] * b + v2 * k);
              y2[r] += S[r][c] * rr;
            }
          }
        }
        float y[4];
#pragma unroll
        for (int r = 0; r < 4; ++r) { float yy = y2[r].x + y2[r].y; yy += dpp_xor1(yy); yy += dpp_xor2(yy); y[r] = yy; }
        if (cgp == 0) {
          const int i = ic + s, t = d ? T - 1 - i : i;
          u32x2 o; o.x = pk2(y[0], y[1]); o.y = pk2(y[2], y[3]);
          *(u32x2*)(YS + (size_t)(start + t) * RWW + rb) = o;
        }
      }
      if (more) lwrite();
    }
    if (chain >= 512) {
      float* st = (float*)(ws + OFF_ST) + ((size_t)(cidx * 16 + hd) * 2 + mode) * 4096;
#pragma unroll
      for (int r = 0; r < 4; ++r)
#pragma unroll
        for (int c = 0; c < 8; ++c) *(f32x2*)(st + (rg * 4 + r) * 64 + cgp * 16 + 2 * c) = S[r][c];
    }
  }
}

DI void phase_scan_fix(const Params& p, unsigned char* ldsb) {
  unsigned char* ws = p.ws;
  const int tid = threadIdx.x, lane = tid & 63, wid = tid >> 6;
  constexpr int NSUB = 2, SUBL = CHL / NSUB;
  float* SA = (float*)ldsb; float* SB = SA + 64 * 65;
  for (int item = blockIdx.x; item < (NCH - 1) * 16 * NSUB; item += gridDim.x) {
    const int c = 1 + item / (16 * NSUB), rem = item % (16 * NSUB), hd = rem / NSUB, sub = rem % NSUB, h = hd >> 1, d = hd & 1;
    const int fi = (tid & 255) >> 2, fj = (tid & 3) * 16;
    float* cur = SA; float* nxt = SB;
    __syncthreads();
    {
      const float* U0 = (const float*)(ws + OFF_ST) + ((size_t)(0 * 16 + hd) * 2 + 0) * 4096;
      if (tid < 256) {
#pragma unroll
        for (int k = 0; k < 16; ++k) cur[fi * 65 + fj + k] = U0[fi * 64 + fj + k];
      }
    }
    __syncthreads();
#pragma unroll 1
    for (int cc = 1; cc < c; ++cc) {
      const float* U = (const float*)(ws + OFF_ST) + ((size_t)(cc * 16 + hd) * 2 + 0) * 4096;
      const float* P = U + 4096;
      if (tid < 256) {
      f32x4 acc[4];
#pragma unroll
      for (int j = 0; j < 4; ++j) acc[j] = *(const f32x4*)(U + fi * 64 + fj + j * 4);
#pragma unroll 4
      for (int m = 0; m < 64; ++m) {
        const float s = cur[fi * 65 + m];
#pragma unroll
        for (int j = 0; j < 4; ++j) acc[j] += *(const f32x4*)(P + m * 64 + fj + j * 4) * s;
      }
#pragma unroll
      for (int j = 0; j < 4; ++j) { nxt[fi * 65 + fj + j * 4] = acc[j].x; nxt[fi * 65 + fj + j * 4 + 1] = acc[j].y; nxt[fi * 65 + fj + j * 4 + 2] = acc[j].z; nxt[fi * 65 + fj + j * 4 + 3] = acc[j].w; }
      }
      __syncthreads();
      float* t2 = cur; cur = nxt; nxt = t2;
    }
    float S[64];
#pragma unroll
    for (int j = 0; j < 64; ++j) S[j] = cur[lane * 65 + j];
    const bf16_t* QB = (const bf16_t*)(ws + OFF_QB + (size_t)d * T_P * RWW * 2);
    bf16_t* YS = (bf16_t*)(ws + OFF_YS + (size_t)d * SEG);
#pragma unroll 1
    for (int i = c * CHL + sub * SUBL + wid; i < c * CHL + (sub + 1) * SUBL; i += NWV) {
      const int t = d ? T_P - 1 - i : i; const size_t o = (size_t)t * RWW + h * 64;
      float corr = 0.f;
#pragma unroll
      for (int c8 = 0; c8 < 8; ++c8) { float q[8]; unpack8(*(const u32x4*)(QB + o + c8 * 8), q);
#pragma unroll
        for (int e = 0; e < 8; ++e) corr += S[c8 * 8 + e] * q[e]; }
      const float y = bf2f(YS[o + lane]) + corr;
      YS[o + lane] = (bf16_t)(pk2(y, 0.f) & 0xffffu);
    }
  }
}

DI void phase_rwfinish(const Params& p, int it_lo, int it_hi) {
  unsigned char* ws = p.ws;
  const bf16_t* YF = (const bf16_t*)(ws + OFF_YS); const bf16_t* YB = (const bf16_t*)(ws + OFF_YS + SEG);
  const bf16_t* R = (const bf16_t*)(ws + OFF_R); const bf16_t* V = (const bf16_t*)(ws + OFF_V); const bf16_t* G = (const bf16_t*)(ws + OFF_G);
  const bf16_t* KF = (const bf16_t*)((const unsigned char*)p.out + 2 * SEG); const bf16_t* KB = (const bf16_t*)((const unsigned char*)p.out + 3 * SEG);
  bf16_t* O = (bf16_t*)p.out;
  const float* r_k = p.in[17]; const float* ln_w = p.in[18]; const float* ln_b = p.in[19];
  const int lane = threadIdx.x & 63, gw = blockIdx.x * NWV + (threadIdx.x >> 6), nw = gridDim.x * NWV;
  for (int it = it_lo + gw; it < it_hi; it += nw) {
    const int row = it >> 1, ch = (it & 1) * 256 + lane * 4;
    const size_t o = (size_t)row * RWW + ch;
    const f32x4 yf = load4(YF + o), yb = load4(YB + o), r = load4(R + o), kf = load4(KF + o), kb = load4(KB + o), v = load4(V + o), g = load4(G + o);
    const f32x4 y = yf + yb;
    const f32x4 rk = *(const f32x4*)(r_k + ch);
    float s = y.x + y.y + y.z + y.w;
    const f32x4 bq = r * (kf + kb) * rk;
    float bs = bq.x + bq.y + bq.z + bq.w;
#pragma unroll
    for (int m = 1; m < 16; m <<= 1) { s += __shfl_xor(s, m); bs += __shfl_xor(bs, m); }
    const float mu = s * (1.f / 64.f);
    const f32x4 dv = y - mu;
    float q = dv.x * dv.x + dv.y * dv.y + dv.z * dv.z + dv.w * dv.w;
#pragma unroll
    for (int m = 1; m < 16; m <<= 1) q += __shfl_xor(q, m);
    const float rs = rsqrtf(q * (1.f / 64.f) + 64e-5f);
    const f32x4 lw = *(const f32x4*)(ln_w + ch), lb = *(const f32x4*)(ln_b + ch);
    const f32x4 res = (dv * rs * lw + lb + v * bs) * g;
    store4(O + o, res);
  }
}

DI void phase_attn(const Params& p, unsigned char* lds) {
  unsigned char* ws = p.ws;
  const bf16_t* qkv = (const bf16_t*)(ws + OFF_QKV);
  bf16_t* oatt = (bf16_t*)(ws + OFF_QKV);
  const int tid = threadIdx.x, lane = tid & 63, wid = tid >> 6, fr = lane & 15, fq = lane >> 4;
  const int kvh = wid >> 2;
  bf16_t* KsAll = (bf16_t*)lds; bf16_t* VtAll = (bf16_t*)(lds + 9216);
  const bf16_t* Ks = KsAll + kvh * (32 * 72);
  const bf16_t* Vt = VtAll + kvh * (64 * 36);
  const int njobs = M_TOK / 32;
  for (int job = blockIdx.x; job < njobs; job += gridDim.x) {
    const int q0 = job * 32;
    int start, T; seq_of(q0, start, T);
    const int h = wid;
    const float slope = exp2f(-(float)(h + 1)), sink = p.in[7][h];
    bf16x8 qf[2][2];
#pragma unroll
    for (int mt = 0; mt < 2; ++mt)
#pragma unroll
      for (int ks = 0; ks < 2; ++ks) qf[mt][ks] = *(const bf16x8*)(qkv + (size_t)(q0 + mt * 16 + fr) * QKVW + h * 64 + ks * 32 + fq * 8);
    f32x4 o[4][2];
#pragma unroll
    for (int a = 0; a < 4; ++a)
#pragma unroll
      for (int b = 0; b < 2; ++b) o[a][b] = (f32x4){0.f, 0.f, 0.f, 0.f};
    float mrun[2], lrun[2];
#pragma unroll
    for (int mt = 0; mt < 2; ++mt) { mrun[mt] = sink; lrun[mt] = fq == 0 ? 1.f : 0.f; }
#pragma unroll 1
    for (int kt = 0; kt < 9; ++kt) {
      const int kb = q0 - 128 + kt * 32, kbr = kb - start;
      if (kbr < 128 || kbr >= T + 128) continue;
      const bool phantom = kbr >= T;
      __syncthreads();
      {
        const int skv = tid >> 8, key = (tid & 255) >> 3, dc = tid & 7;
        const bf16_t* src = qkv + (size_t)(kb + key) * QKVW + 512 + skv * 64 + dc * 8;
        u32x4 kvv = {0u, 0u, 0u, 0u}, vv = {0u, 0u, 0u, 0u};
        if (!phantom) { kvv = *(const u32x4*)src; vv = *(const u32x4*)(src + 128); }
        bf16_t* Vw = VtAll + skv * (64 * 36);
        *(u32x4*)(KsAll + skv * (32 * 72) + key * 72 + dc * 8) = kvv;
        const unsigned w[4] = {vv.x, vv.y, vv.z, vv.w};
#pragma unroll
        for (int e = 0; e < 4; ++e) { Vw[(dc * 8 + 2 * e) * 36 + key] = (bf16_t)(w[e] & 0xffffu); Vw[(dc * 8 + 2 * e + 1) * 36 + key] = (bf16_t)(w[e] >> 16); }
      }
      __syncthreads();
#pragma unroll
      for (int mt = 0; mt < 2; ++mt) {
        f32x4 s[2];
#pragma unroll
        for (int nt = 0; nt < 2; ++nt) {
          s[nt] = (f32x4){0.f, 0.f, 0.f, 0.f};
#pragma unroll
          for (int ks = 0; ks < 2; ++ks) {
            const bf16x8 kf = *(const bf16x8*)(Ks + (nt * 16 + fr) * 72 + ks * 32 + fq * 8);
            s[nt] = __builtin_amdgcn_mfma_f32_16x16x32_bf16(kf, qf[mt][ks], s[nt], 0, 0, 0);
          }
        }
        const int tq = q0 + mt * 16 + fr;
        float mx = -1e30f;
#pragma unroll
        for (int nt = 0; nt < 2; ++nt)
#pragma unroll
          for (int j = 0; j < 4; ++j) {
            const int tk = kb + nt * 16 + fq * 4 + j; const int dist = tq > tk ? tq - tk : tk - tq;
            const float sc = dist <= 128 ? s[nt][j] * 0.125f - slope * (float)dist : -1e30f;
            s[nt][j] = sc; mx = fmaxf(mx, sc);
          }
        mx = fmaxf(mx, __shfl_xor(mx, 16)); mx = fmaxf(mx, __shfl_xor(mx, 32));
        const float mnew = fmaxf(mrun[mt], mx), alpha = __expf(mrun[mt] - mnew);
        mrun[mt] = mnew;
        float ls = 0.f;
#pragma unroll
        for (int nt = 0; nt < 2; ++nt)
#pragma unroll
          for (int j = 0; j < 4; ++j) { const float pe = __expf(s[nt][j] - mnew); s[nt][j] = pe; ls += pe; }
        lrun[mt] = lrun[mt] * alpha + ls;
#pragma unroll
        for (int dt = 0; dt < 4; ++dt) o[dt][mt] = o[dt][mt] * alpha;
        u32x4 pu; pu.x = pk2(s[0][0], s[0][1]); pu.y = pk2(s[0][2], s[0][3]); pu.z = pk2(s[1][0], s[1][1]); pu.w = pk2(s[1][2], s[1][3]);
        const bf16x8 pf = __builtin_bit_cast(bf16x8, pu);
#pragma unroll
        for (int dt = 0; dt < 4; ++dt) {
          const bf16_t* vrow = Vt + (dt * 16 + fr) * 36 + fq * 4;
          u32x4 vu; const u32x2 v0 = *(const u32x2*)(vrow), v1 = *(const u32x2*)(vrow + 16);
          vu.x = v0.x; vu.y = v0.y; vu.z = v1.x; vu.w = v1.y;
          o[dt][mt] = __builtin_amdgcn_mfma_f32_16x16x32_bf16(__builtin_bit_cast(bf16x8, vu), pf, o[dt][mt], 0, 0, 0);
        }
      }
    }
#pragma unroll
    for (int mt = 0; mt < 2; ++mt) {
      float l = lrun[mt]; l += __shfl_xor(l, 16); l += __shfl_xor(l, 32);
      const float inv = 1.f / l;
#pragma unroll
      for (int dt = 0; dt < 4; ++dt) store4(oatt + (size_t)(q0 + mt * 16 + fr) * QKVW + h * 64 + dt * 16 + fq * 4, o[dt][mt] * inv);
    }
  }
}


DI void phase_attn_wave(const Params& p, unsigned char* ldsw, int first, int stride) {
  unsigned char* ws = p.ws;
  const bf16_t* qkv = (const bf16_t*)(ws + OFF_QKV);
  bf16_t* oatt = (bf16_t*)(ws + OFF_QKV);
  const int lane = threadIdx.x & 63, fr = lane & 15, fq = lane >> 4;
  bf16_t* Ks = (bf16_t*)ldsw;
  bf16_t* Vt = (bf16_t*)(ldsw + 4608);
  const int njobs = (M_TOK / 32) * 8;
  for (int job = first; job < njobs; job += stride) {
    const int q0 = (job >> 3) * 32, h = job & 7, kvh = h >> 2;
    int start, T; seq_of(q0, start, T);
    const float slope = exp2f(-(float)(h + 1)), sink = p.in[7][h];
    bf16x8 qf[2][2];
#pragma unroll
    for (int mt = 0; mt < 2; ++mt)
#pragma unroll
      for (int ks = 0; ks < 2; ++ks) qf[mt][ks] = *(const bf16x8*)(qkv + (size_t)(q0 + mt * 16 + fr) * QKVW + h * 64 + ks * 32 + fq * 8);
    f32x4 o[4][2];
#pragma unroll
    for (int a = 0; a < 4; ++a)
#pragma unroll
      for (int b = 0; b < 2; ++b) o[a][b] = (f32x4){0.f, 0.f, 0.f, 0.f};
    float mrun[2], lrun[2];
#pragma unroll
    for (int mt = 0; mt < 2; ++mt) { mrun[mt] = sink; lrun[mt] = fq == 0 ? 1.f : 0.f; }
#pragma unroll 1
    for (int kt = 0; kt < 9; ++kt) {
      const int kb = q0 - 128 + kt * 32, kbr = kb - start;
      if (kbr < 128 || kbr >= T + 128) continue;
      const bool phantom = kbr >= T;
      asm volatile("" ::: "memory");
#pragma unroll
      for (int i = 0; i < 4; ++i) {
        const int c = lane + 64 * i, key = c >> 3, dc = c & 7;
        const bf16_t* src = qkv + (size_t)(kb + key) * QKVW + 512 + kvh * 64 + dc * 8;
        u32x4 kvv = {0u, 0u, 0u, 0u}, vv = {0u, 0u, 0u, 0u};
        if (!phantom) { kvv = *(const u32x4*)src; vv = *(const u32x4*)(src + 128); }
        *(u32x4*)(Ks + key * 72 + dc * 8) = kvv;
        const unsigned w[4] = {vv.x, vv.y, vv.z, vv.w};
#pragma unroll
        for (int e = 0; e < 4; ++e) { Vt[(dc * 8 + 2 * e) * 36 + key] = (bf16_t)(w[e] & 0xffffu); Vt[(dc * 8 + 2 * e + 1) * 36 + key] = (bf16_t)(w[e] >> 16); }
      }
      asm volatile("s_waitcnt lgkmcnt(0)" ::: "memory");
#pragma unroll
      for (int mt = 0; mt < 2; ++mt) {
        f32x4 s[2];
#pragma unroll
        for (int nt = 0; nt < 2; ++nt) {
          s[nt] = (f32x4){0.f, 0.f, 0.f, 0.f};
#pragma unroll
          for (int ks = 0; ks < 2; ++ks) {
            const bf16x8 kf = *(const bf16x8*)(Ks + (nt * 16 + fr) * 72 + ks * 32 + fq * 8);
            s[nt] = __builtin_amdgcn_mfma_f32_16x16x32_bf16(kf, qf[mt][ks], s[nt], 0, 0, 0);
          }
        }
        const int tq = q0 + mt * 16 + fr;
        float mx = -1e30f;
#pragma unroll
        for (int nt = 0; nt < 2; ++nt)
#pragma unroll
          for (int j = 0; j < 4; ++j) {
            const int tk = kb + nt * 16 + fq * 4 + j; const int dist = tq > tk ? tq - tk : tk - tq;
            const float sc = dist <= 128 ? s[nt][j] * 0.125f - slope * (float)dist : -1e30f;
            s[nt][j] = sc; mx = fmaxf(mx, sc);
          }
        mx = fmaxf(mx, __shfl_xor(mx, 16)); mx = fmaxf(mx, __shfl_xor(mx, 32));
        const float mnew = fmaxf(mrun[mt], mx), alpha = __expf(mrun[mt] - mnew);
        mrun[mt] = mnew;
        float ls = 0.f;
#pragma unroll
        for (int nt = 0; nt < 2; ++nt)
#pragma unroll
          for (int j = 0; j < 4; ++j) { const float pe = __expf(s[nt][j] - mnew); s[nt][j] = pe; ls += pe; }
        lrun[mt] = lrun[mt] * alpha + ls;
#pragma unroll
        for (int dt = 0; dt < 4; ++dt) o[dt][mt] = o[dt][mt] * alpha;
        u32x4 pu; pu.x = pk2(s[0][0], s[0][1]); pu.y = pk2(s[0][2], s[0][3]); pu.z = pk2(s[1][0], s[1][1]); pu.w = pk2(s[1][2], s[1][3]);
        const bf16x8 pf = __builtin_bit_cast(bf16x8, pu);
#pragma unroll
        for (int dt = 0; dt < 4; ++dt) {
          const bf16_t* vrow = Vt + (dt * 16 + fr) * 36 + fq * 4;
          u32x4 vu; const u32x2 v0 = *(const u32x2*)(vrow), v1 = *(const u32x2*)(vrow + 16);
          vu.x = v0.x; vu.y = v0.y; vu.z = v1.x; vu.w = v1.y;
          o[dt][mt] = __builtin_amdgcn_mfma_f32_16x16x32_bf16(__builtin_bit_cast(bf16x8, vu), pf, o[dt][mt], 0, 0, 0);
        }
      }
    }
#pragma unroll
    for (int mt = 0; mt < 2; ++mt) {
      float l = lrun[mt]; l += __shfl_xor(l, 16); l += __shfl_xor(l, 32);
      const float inv = 1.f / l;
#pragma unroll
      for (int dt = 0; dt < 4; ++dt) store4(oatt + (size_t)(q0 + mt * 16 + fr) * QKVW + h * 64 + dt * 16 + fq * 4, o[dt][mt] * inv);
    }
  }
}

#ifndef NAIVE_ATTN
#define NAIVE_ATTN 0
#endif
#ifndef NAIVE_SCAN
#define NAIVE_SCAN 0
#endif
DI void phase_attn_naive(const Params& p) {
  unsigned char* ws = p.ws;
  const bf16_t* qkv = (const bf16_t*)(ws + OFF_QKV);
  bf16_t* oatt = (bf16_t*)(ws + OFF_QKV);
  const int lane = threadIdx.x & 63, gw = blockIdx.x * NWV + (threadIdx.x >> 6), nw = gridDim.x * NWV;
  for (int item = gw; item < M_TOK * 8; item += nw) {
    const int row = item >> 3, h = item & 7, kvh = h >> 2;
    int start, T; seq_of(row, start, T);
    const float slope = exp2f(-(float)(h + 1)), sink = p.in[7][h];
    const float q = bf2f(qkv[(size_t)row * QKVW + h * 64 + lane]);
    const int lo = max(row - 128, start + 128), hi = min(row + 128, start + T + 127);
    float m = sink, l = 1.f, acc = 0.f;
    for (int s = lo; s <= hi; ++s) {
      const bool real = s < start + T;
      const float kx = real ? bf2f(qkv[(size_t)s * QKVW + 512 + kvh * 64 + lane]) : 0.f;
      const float vx = real ? bf2f(qkv[(size_t)s * QKVW + 640 + kvh * 64 + lane]) : 0.f;
      const int dist = row > s ? row - s : s - row;
      const float sc = wave_sum(q * kx) * 0.125f - slope * (float)dist;
      const float mnew = fmaxf(m, sc), alpha = __expf(m - mnew), pe = __expf(sc - mnew);
      l = l * alpha + pe; acc = acc * alpha + pe * vx; m = mnew;
    }
    oatt[(size_t)row * QKVW + h * 64 + lane] = (bf16_t)(pk2(acc / l, 0.f) & 0xffffu);
  }
}
DI void phase_scan_naive(const Params& p) {
  unsigned char* ws = p.ws;
  const bf16_t* R = (const bf16_t*)(ws + OFF_R); const bf16_t* V = (const bf16_t*)(ws + OFF_V); const bf16_t* NKK = (const bf16_t*)(ws + OFF_NKK);
  const int wid = threadIdx.x >> 6, lane = threadIdx.x & 63;
  for (int chain = wid * gridDim.x + blockIdx.x; chain < 33 * 16; chain += 4 * gridDim.x) {
    const int seq = chain >> 4, hd = chain & 15, h = hd >> 1, d = hd & 1;
    const int start = seq == 0 ? 0 : T_P + (seq - 1) * T_S, T = seq == 0 ? T_P : T_S;
    const bf16_t* Wd = (const bf16_t*)((const unsigned char*)p.out + (size_t)d * SEG);
    const bf16_t* Kd = (const bf16_t*)((const unsigned char*)p.out + (size_t)(2 + d) * SEG);
    const bf16_t* Bd = (const bf16_t*)(ws + OFF_BF + (size_t)d * SEG);
    bf16_t* YS = (bf16_t*)(ws + OFF_YS + (size_t)d * SEG);
    float S[64];
#pragma unroll
    for (int j = 0; j < 64; ++j) S[j] = 0.f;
    for (int i = 0; i < T; ++i) {
      const int t = d ? T - 1 - i : i; const size_t o = (size_t)(start + t) * RWW + h * 64;
      const float v = bf2f(V[o + lane]);
      float sa = 0.f;
#pragma unroll
      for (int c = 0; c < 8; ++c) { float a[8]; unpack8(*(const u32x4*)(NKK + o + c * 8), a);
#pragma unroll
        for (int e = 0; e < 8; ++e) sa += S[c * 8 + e] * a[e]; }
      float y = 0.f;
#pragma unroll
      for (int c = 0; c < 8; ++c) { float w[8], k[8], b[8], r[8];
        unpack8(*(const u32x4*)(Wd + o + c * 8), w); unpack8(*(const u32x4*)(Kd + o + c * 8), k); unpack8(*(const u32x4*)(Bd + o + c * 8), b); unpack8(*(const u32x4*)(R + o + c * 8), r);
#pragma unroll
        for (int e = 0; e < 8; ++e) { const float sn = S[c * 8 + e] * (1.f - w[e]) + sa * b[e] + v * k[e]; S[c * 8 + e] = sn; y += sn * r[e]; } }
      YS[o + lane] = (bf16_t)(pk2(y, 0.f) & 0xffffu);
    }
  }
}
DI void phase_row_h(const Params& p) {
  unsigned char* ws = p.ws;
  const bf16_t* MO = (const bf16_t*)(ws + OFF_MO); bf16_t* HB = (bf16_t*)(ws + OFF_HB); float* rstdh = (float*)(ws + OFF_RSTDH);
  const float* g = p.in[3];
  const int lane = threadIdx.x & 63, gw = blockIdx.x * NWV + (threadIdx.x >> 6), nw = gridDim.x * NWV;
  for (int row = gw; row < M_TOK; row += nw) {
    const float* xs = row < T_P ? p.in[0] + (size_t)row * DM : p.in[1] + (size_t)(row - T_P) * DM;
    float m[16]; float ss = 0.f;
#pragma unroll
    for (int i = 0; i < 2; ++i) unpack8(*(const u32x4*)(MO + (size_t)row * DM + i * 512 + lane * 8), m + i * 8);
#pragma unroll
    for (int e = 0; e < 16; ++e) ss += m[e] * m[e];
    ss = wave_sum(ss);
    const float rs = rsqrtf(ss * (1.f / DM) + 1e-6f);
    float hs = 0.f; float hv[16];
#pragma unroll
    for (int i = 0; i < 2; ++i)
#pragma unroll
      for (int q = 0; q < 2; ++q) {
        const int c = i * 512 + lane * 8 + q * 4;
        const f32x4 xv = *(const f32x4*)(xs + c), gv = *(const f32x4*)(g + c);
        f32x4 hh;
#pragma unroll
        for (int e = 0; e < 4; ++e) { hh[e] = xv[e] + m[i * 8 + q * 4 + e] * rs * gv[e]; hv[i * 8 + q * 4 + e] = hh[e]; hs += hh[e] * hh[e]; }
        *(f32x4*)(p.out + (size_t)row * DM + c) = hh;
      }
#pragma unroll
    for (int i = 0; i < 2; ++i) *(u32x4*)(HB + (size_t)row * DM + i * 512 + lane * 8) = pack8(hv + i * 8);
    hs = wave_sum(hs);
    if (lane == 0) rstdh[row] = rsqrtf(hs * (1.f / DM) + 1e-6f);
  }
}
DI void phase_row_out(const Params& p) {
  unsigned char* ws = p.ws;
  const bf16_t* F = (const bf16_t*)(ws + OFF_F);
  const float* g = p.in[5];
  const int lane = threadIdx.x & 63, gw = blockIdx.x * NWV + (threadIdx.x >> 6), nw = gridDim.x * NWV;
  for (int row = gw; row < M_TOK; row += nw) {
    float m[16]; float ss = 0.f;
#pragma unroll
    for (int i = 0; i < 2; ++i) unpack8(*(const u32x4*)(F + (size_t)row * DM + i * 512 + lane * 8), m + i * 8);
#pragma unroll
    for (int e = 0; e < 16; ++e) ss += m[e] * m[e];
    ss = wave_sum(ss);
    const float rs = rsqrtf(ss * (1.f / DM) + 1e-6f);
#pragma unroll
    for (int i = 0; i < 2; ++i)
#pragma unroll
      for (int q = 0; q < 2; ++q) {
        const int c = i * 512 + lane * 8 + q * 4;
        float* op = p.out + (size_t)row * DM + c;
        const f32x4 hv = *(const f32x4*)op, gv = *(const f32x4*)(g + c);
        f32x4 r;
#pragma unroll
        for (int e = 0; e < 4; ++e) r[e] = hv[e] + m[i * 8 + q * 4 + e] * rs * gv[e];
        *(f32x4*)op = r;
      }
  }
}
DI void phase_convglu(const Params& p, int hf) {
  unsigned char* ws = p.ws;
  const bf16_t* HUP = (const bf16_t*)(ws + OFF_HUP); bf16_t* ACT = (bf16_t*)(ws + (hf ? OFF_ACT1 : OFF_ACT));
  const float* cw = p.in[24]; const float* cbias = p.in[25];
  constexpr int RB = 16, NCHK = DFF / 8;
  const int total = (HALF_ROWS / RB) * NCHK;
  for (int idx = blockIdx.x * NTHR + threadIdx.x; idx < total; idx += gridDim.x * NTHR) {
    const int rbk = idx / NCHK, c = (idx % NCHK) * 8, lr0 = rbk * RB, row0 = hf * HALF_ROWS + lr0;
    int start, T; seq_of(row0, start, T);
    const int pos0 = row0 - start;
    float w[2][3][8], bs[2][8];
#pragma unroll
    for (int part = 0; part < 2; ++part) {
#pragma unroll
      for (int d = 0; d < 3; ++d) {
        const f32x4 a = *(const f32x4*)(cw + d * 2 * DFF + part * DFF + c), b = *(const f32x4*)(cw + d * 2 * DFF + part * DFF + c + 4);
        w[part][d][0] = a.x; w[part][d][1] = a.y; w[part][d][2] = a.z; w[part][d][3] = a.w; w[part][d][4] = b.x; w[part][d][5] = b.y; w[part][d][6] = b.z; w[part][d][7] = b.w;
      }
      const f32x4 a = *(const f32x4*)(cbias + part * DFF + c), b = *(const f32x4*)(cbias + part * DFF + c + 4);
      bs[part][0] = a.x; bs[part][1] = a.y; bs[part][2] = a.z; bs[part][3] = a.w; bs[part][4] = b.x; bs[part][5] = b.y; bs[part][6] = b.z; bs[part][7] = b.w;
    }
    const bf16_t* hp = HUP + (size_t)lr0 * (2 * DFF) + c;
    float prev[2][8], cur[2][8], nxt[2][8];
#pragma unroll
    for (int part = 0; part < 2; ++part) {
      if (pos0 > 0) unpack8(*(const u32x4*)(hp - 2 * DFF + part * DFF), prev[part]); else { for (int e = 0; e < 8; ++e) prev[part][e] = 0.f; }
      unpack8(*(const u32x4*)(hp + part * DFF), cur[part]);
    }
#pragma unroll
    for (int r = 0; r < RB; ++r) {
      const bool hasn = pos0 + r < T - 1;
#pragma unroll
      for (int part = 0; part < 2; ++part) {
        if (hasn) unpack8(*(const u32x4*)(hp + (size_t)(r + 1) * (2 * DFF) + part * DFF), nxt[part]); else { for (int e = 0; e < 8; ++e) nxt[part][e] = 0.f; }
      }
      float o[8];
#pragma unroll
      for (int e = 0; e < 8; ++e) {
        const float x = prev[0][e] * w[0][0][e] + cur[0][e] * w[0][1][e] + nxt[0][e] * w[0][2][e] + bs[0][e];
        const float up = prev[1][e] * w[1][0][e] + cur[1][e] * w[1][1][e] + nxt[1][e] * w[1][2][e] + bs[1][e];
        const float u = 0.7978845608028654f * (x + 0.044715f * x * x * x);
        const float t2 = __expf(2.f * u); const float th = 1.f - 2.f / (t2 + 1.f);
        o[e] = 0.5f * x * (1.f + th) * up;
      }
      *(u32x4*)(ACT + (size_t)(lr0 + r) * DFF + c) = pack8(o);
#pragma unroll
      for (int part = 0; part < 2; ++part)
#pragma unroll
        for (int e = 0; e < 8; ++e) { prev[part][e] = cur[part][e]; cur[part][e] = nxt[part][e]; }
    }
  }
}

constexpr int NPHASE = 18;
constexpr int LDS_BYTES = 2 * STAGE8;
static_assert(LDS_BYTES >= 2 * 64 * 65 * 4 && LDS_BYTES >= 9216 + 64 * 68 * 2, "lds");

template <int PH>
DI void run_phase(const Params& p, unsigned char* lds) {
  unsigned char* ws = p.ws;
  if constexpr (PH == 0) phase_prep(p, lds);
  else if constexpr (PH == 1) { EpiScaleStore e{(bf16_t*)p.out, ZLD, (const float*)(ws + OFF_RSTDX), 0};
    gemm_phase((const bf16_t*)(ws + OFF_XB), DM, (const bf16_t*)(ws + OFF_WZT), DM, DM, 0, M_TOK, ZLD, lds, e); }
  else if constexpr (PH == 2) phase_rwprep(p);
  else if constexpr (PH == 3) {
#pragma unroll 1
    for (int d = 0; d < 2; ++d) {
      EpiW ew{(bf16_t*)((unsigned char*)p.out + (size_t)d * SEG), p.in[10] + d * 512};
      gemm_phase((const bf16_t*)(ws + OFF_LIN) + d * 64, LINW, (const bf16_t*)(ws + OFF_W2T) + d * 512 * 64, 64, 64, 0, M_TOK, RWW, lds, ew, d * 128);
      EpiA ea{(bf16_t*)((unsigned char*)p.out + (size_t)(2 + d) * SEG), (bf16_t*)(ws + OFF_BF + (size_t)d * SEG), (const bf16_t*)(ws + OFF_KSH),
              (const bf16_t*)(ws + OFF_NKK), p.in[12] + d * 512, p.in[16]};
      gemm_phase((const bf16_t*)(ws + OFF_LIN) + 128 + d * 64, LINW, (const bf16_t*)(ws + OFF_A2T) + d * 512 * 64, 64, 64, 0, M_TOK, RWW, lds, ea, 128 - d * 128);
    }
    EpiStore eg{(bf16_t*)(ws + OFF_G), RWW};
    gemm_phase((const bf16_t*)(ws + OFF_LIN) + 256, LINW, (const bf16_t*)(ws + OFF_G2T), 160, 160, 0, M_TOK, RWW, lds, eg);
  }
  else if constexpr (PH == 4) { EpiQG e{(bf16_t*)(ws + OFF_QKV), nullptr, (const float*)(ws + OFF_RSTDX)};
    gemm_phase((const bf16_t*)(ws + OFF_XB), DM, (const bf16_t*)(ws + OFF_WQGT), DM, DM, 0, M_TOK, QKVW, lds, e); }
  else if constexpr (PH == 5) {
    const int wid = threadIdx.x >> 6;
    if (wid < 3) phase_scan(p, lds);
    else if ((wid & 3) == 3) phase_attn_wave(p, lds + 3 * SCAN_WLDS + (wid >> 2) * 9216, (int)blockIdx.x * 2 + (wid >> 2), (int)gridDim.x * 2);
  }
  else if constexpr (PH == 6) { phase_scan_fix(p, lds); phase_rwfinish(p, 2 * T_P, 2 * M_TOK); }
  else if constexpr (PH == 7) phase_rwfinish(p, 0, 2 * T_P);
  else if constexpr (PH == 8) { EpiGate e{(bf16_t*)(ws + OFF_SG), (const float*)(ws + OFF_RSTDX)};
    gemm_phase((const bf16_t*)(ws + OFF_XB), DM, (const bf16_t*)(ws + OFF_WQGT) + (size_t)QKVW * DM, DM, DM, 0, M_TOK, SGW, lds, e); }
  else if constexpr (PH == 9) {
    EpiMerge1 e1{(bf16_t*)(ws + OFF_MERGED), (const bf16_t*)(ws + OFF_SG)};
    EpiMerge2 e2{(bf16_t*)(ws + OFF_MERGED), (const bf16_t*)(ws + OFF_SG)};
    const int ntn = DM / T8, ntm = M_TOK / T8;
    for (int t = blockIdx.x; t < ntn * ntm; t += gridDim.x) {
      int tm, tn; tile_of(t, ntm, ntn, tm, tn);
      gemm_tile8((const bf16_t*)(ws + OFF_QKV), QKVW, (const bf16_t*)(ws + OFF_WAT), 512, 512, tm * T8, tn * T8, lds, e1);
    }
    asm volatile("" ::: "memory");
    for (int t = blockIdx.x; t < ntn * ntm; t += gridDim.x) {
      int tm, tn; tile_of(t, ntm, ntn, tm, tn);
      gemm_tile8((const bf16_t*)p.out, 512, (const bf16_t*)(ws + OFF_WBT), 512, 512, tm * T8, tn * T8, lds, e2);
    }
  }
  else if constexpr (PH == 10) { EpiStore e{(bf16_t*)(ws + OFF_MO), DM};
    gemm_phase((const bf16_t*)(ws + OFF_MERGED), DM, (const bf16_t*)(ws + OFF_WOT), DM, DM, 0, M_TOK, DM, lds, e); }
  else if constexpr (PH == 11) phase_row_h(p);
  else if constexpr (PH == 12 || PH == 14) { constexpr int hf = PH == 12 ? 0 : 1;
    EpiScaleStore e{(bf16_t*)(ws + OFF_HUP), 2 * DFF, (const float*)(ws + OFF_RSTDH), hf * HALF_ROWS};
    gemm_phase((const bf16_t*)(ws + OFF_HB), DM, (const bf16_t*)(ws + OFF_WUPT), DM, DM, hf * HALF_ROWS, HALF_ROWS, 2 * DFF, lds, e); }
  else if constexpr (PH == 13 || PH == 15) phase_convglu(p, PH == 13 ? 0 : 1);
  else if constexpr (PH == 16) {
    EpiStore e{(bf16_t*)(ws + OFF_F), DM};
    const bf16_t* A0 = (const bf16_t*)(ws + OFF_ACT);
    const bf16_t* A1 = (const bf16_t*)(ws + OFF_ACT1) - (size_t)HALF_ROWS * DFF;
    const int ntn = DM / T8, ntm = M_TOK / T8;
    for (int t = blockIdx.x; t < ntn * ntm; t += gridDim.x) {
      int tm, tn; tile_of(t, ntm, ntn, tm, tn);
      gemm_tile8(tm * T8 < HALF_ROWS ? A0 : A1, DFF, (const bf16_t*)(ws + OFF_WDNT), DFF, DFF, tm * T8, tn * T8, lds, e);
    }
  }
  else if constexpr (PH == 17) phase_row_out(p);
}

constexpr size_t OFF_BAR = 1016 * MBY;
DI void grid_barrier(const Params& p, int k) {
  __syncthreads();
  if (threadIdx.x == 0) {
    unsigned* base = (unsigned*)(p.ws + OFF_BAR);
    const int g = blockIdx.x & 7, G = gridDim.x, ng = (G - g + 7) >> 3;
    const unsigned ngroups = G < 8 ? G : 8;
    __builtin_amdgcn_fence(__ATOMIC_RELEASE, "agent");
    const unsigned old = __hip_atomic_fetch_add(base + g * 64, 1u, __ATOMIC_RELAXED, __HIP_MEMORY_SCOPE_AGENT);
    if (old + 1 == (unsigned)(k * ng)) __hip_atomic_fetch_add(base + 8 * 64, 1u, __ATOMIC_RELAXED, __HIP_MEMORY_SCOPE_AGENT);
    while (__hip_atomic_load(base + 8 * 64, __ATOMIC_RELAXED, __HIP_MEMORY_SCOPE_AGENT) < (unsigned)k * ngroups) __builtin_amdgcn_s_sleep(1);
    __builtin_amdgcn_fence(__ATOMIC_ACQUIRE, "agent");
  }
  __syncthreads();
}

template <int PH>
DI void run_all(const Params& p, unsigned char* lds) {
  run_phase<PH>(p, lds);
  if constexpr (((DUP_MASK >> PH) & 1) != 0) { __syncthreads(); run_phase<PH>(p, lds); }
  if constexpr (PH + 1 < NPHASE) {
    if constexpr (PH == 0) cg::this_grid().sync();
    else grid_barrier(p, PH);
    run_all<PH + 1>(p, lds);
  }
}

__global__ void __launch_bounds__(512) mega_coop(Params p) {
  __shared__ __attribute__((aligned(16))) unsigned char lds[LDS_BYTES];
  if (blockIdx.x == 0 && threadIdx.x < 16) __hip_atomic_store((unsigned*)(p.ws + OFF_BAR) + threadIdx.x * 64, 0u, __ATOMIC_RELAXED, __HIP_MEMORY_SCOPE_AGENT);
  run_all<0>(p, lds);
}

template <int PH>
__global__ void __launch_bounds__(512) mega_one(Params p) {
  __shared__ __attribute__((aligned(16))) unsigned char lds[LDS_BYTES];
  run_phase<PH>(p, lds);
}

template <int PH>
static void launch_all(const Params& p, int grid, hipStream_t stream) {
  hipLaunchKernelGGL(mega_one<PH>, dim3(grid), dim3(NTHR), 0, stream, p);
  if constexpr (PH + 1 < NPHASE) launch_all<PH + 1>(p, grid, stream);
}

extern "C" void kernel_launch(void* const* d_in, const int* in_sizes, int n_in, void* d_out, int out_size, void* d_ws, size_t ws_size,
                              hipStream_t stream) {
  static int grid_blocks = 0;
  if (!grid_blocks) {
    int dev = 0, cus = 0, per_cu = 0;
    (void)hipGetDevice(&dev);
    (void)hipDeviceGetAttribute(&cus, hipDeviceAttributeMultiprocessorCount, dev);
    (void)hipOccupancyMaxActiveBlocksPerMultiprocessor(&per_cu, mega_coop, NTHR, 0);
    if (per_cu < 1) per_cu = 1;
    if (per_cu > 1) per_cu = 1;
    grid_blocks = cus * per_cu;
    if (ws_size < 1014 * MBY) fprintf(stderr, "kernel_launch: workspace too small (%zu)\n", ws_size);
  }
  Params p{};
  for (int i = 0; i < 27; ++i) p.in[i] = (const float*)d_in[i];
  p.out = (float*)d_out; p.ws = (unsigned char*)d_ws;
  if (COOP_MODE) {
    void* args[] = {&p};
    hipError_t e = hipLaunchCooperativeKernel((void*)mega_coop, dim3(grid_blocks), dim3(NTHR), args, 0, stream);
    if (e != hipSuccess) fprintf(stderr, "cooperative launch failed: %s (grid %d)\n", hipGetErrorString(e), grid_blocks);
  } else {
    launch_all<0>(p, grid_blocks, stream);
  }
}
```
